# Optimizing an MI355X kernel written in HIP

```python
import jax, jax.numpy as jnp
from jax import lax
import numpy as np

D_MODEL = 2048
BATCH = 8
SEQ = 4096
DEPTH = 2
DEC_BATCH = 8
DEC_SEQ = 16
PAST_LEN = 4096

CHUNK = 64
Q_BLOCK = 128
N_MIXERS = 2
N_SB_LAYERS = (DEPTH + 1) // 2
N_GLA_LAYERS = DEPTH // 2
SB_HEADS = 16
SB_HEAD_DIM = D_MODEL // SB_HEADS
SB_WIDTH = SB_HEADS * SB_HEAD_DIM
GLA_HEADS = 4
GLA_DK = (D_MODEL // 2) // GLA_HEADS
GLA_DV = D_MODEL // GLA_HEADS
GLA_GATE_RANK = 16
GLA_TAU = 16.0
GLA_IN = 2 * GLA_HEADS * GLA_DK + 2 * GLA_HEADS * GLA_DV + GLA_GATE_RANK
EPS = 1e-6

kernel_name = "sb_gla_hybrid_stream_step"


def rmsnorm(x, g):
    xf = x.astype(jnp.float32)
    y = xf * lax.rsqrt(jnp.mean(xf * xf, axis=-1, keepdims=True) + EPS)
    return (y * g.astype(jnp.float32)).astype(x.dtype)


def sb_block(q, qpos, k, v, kpos):
    z = jnp.einsum('bqhd,bkhd->bhqk', q, k).astype(jnp.float32) * (SB_HEAD_DIM ** -0.5)
    mask = kpos[None, :] < qpos[:, None]
    neg_log_keep = jnp.where(mask, jax.nn.softplus(z), 0.0)
    between = lax.cumsum(neg_log_keep, axis=3, reverse=True) - neg_log_keep
    a = jnp.where(mask, jnp.exp(jax.nn.log_sigmoid(z) - between), 0.0)
    return jnp.einsum('bhqk,bkhd->bqhd', a, v.astype(jnp.float32))


def sb_mixer(h, w_in, w_out, past_k=None, past_v=None):
    B, T, _ = h.shape
    q, k, v, zg = jnp.split(h @ w_in, 4, axis=-1)
    shp = (B, T, SB_HEADS, SB_HEAD_DIM)
    q, k, v = q.reshape(shp), k.reshape(shp), v.reshape(shp)
    if past_k is None:
        nb = T // Q_BLOCK
        pos = jnp.arange(T, dtype=jnp.int32)
        qb = q.reshape(B, nb, Q_BLOCK, SB_HEADS, SB_HEAD_DIM).transpose(1, 0, 2, 3, 4)
        o = lax.map(lambda a: sb_block(a[0], a[1], k, v, pos), (qb, pos.reshape(nb, Q_BLOCK)))
        o = o.transpose(1, 0, 2, 3, 4).reshape(B, T, SB_WIDTH)
    else:
        P = past_k.shape[1]
        keys = jnp.concatenate([past_k, k], axis=1)
        vals = jnp.concatenate([past_v, v], axis=1)
        kpos = jnp.arange(P + T, dtype=jnp.int32)
        qpos = P + jnp.arange(T, dtype=jnp.int32)
        o = sb_block(q, qpos, keys, vals, kpos).reshape(B, T, SB_WIDTH)
    y = (o * jax.nn.silu(zg.astype(jnp.float32))).astype(h.dtype) @ w_out
    return y, k, v


def gla_chunk(S, inp):
    q, k, v, g = inp
    C = q.shape[1]
    b = jnp.cumsum(g, axis=1)
    b_last = b[:, -1]
    q_in = q * jnp.exp(b)
    a = jnp.einsum('bchd,bshd->bhcs', q_in, k * jnp.exp(-b))
    a = jnp.where(jnp.tril(jnp.ones((C, C), dtype=bool)), a, 0.0)
    o = jnp.einsum('bhcs,bshe->bche', a, v) + jnp.einsum('bchd,bhde->bche', q_in, S)
    S = jnp.exp(b_last)[..., None] * S + jnp.einsum('bshd,bshe->bhde', k * jnp.exp(b_last[:, None] - b), v)
    return S, o


def gla_mixer(h, w_in, w_a2, b_a, g_out, w_out, S0=None):
    B, T, _ = h.shape
    f32 = jnp.float32
    nk = GLA_HEADS * GLA_DK
    nv = GLA_HEADS * GLA_DV
    q, k, v, r, a_lr = jnp.split(h @ w_in, [nk, 2 * nk, 2 * nk + nv, 2 * nk + 2 * nv], axis=-1)
    q = q.astype(f32).reshape(B, T, GLA_HEADS, GLA_DK) * (GLA_DK ** -0.5)
    k = k.astype(f32).reshape(B, T, GLA_HEADS, GLA_DK)
    v = v.astype(f32).reshape(B, T, GLA_HEADS, GLA_DV)
    g = (jax.nn.log_sigmoid((a_lr @ w_a2 + b_a).astype(f32)) / GLA_TAU).reshape(B, T, GLA_HEADS, GLA_DK)
    S0 = jnp.zeros((B, GLA_HEADS, GLA_DK, GLA_DV), f32) if S0 is None else S0.astype(f32)
    C = min(CHUNK, T)
    nc = T // C
    to_chunks = lambda t: t.reshape(B, nc, C, *t.shape[2:]).swapaxes(0, 1)
    S, o = lax.scan(gla_chunk, S0, (to_chunks(q), to_chunks(k), to_chunks(v), to_chunks(g)))
    o = o.swapaxes(0, 1).reshape(B, T, GLA_HEADS, GLA_DV)
    o = o * lax.rsqrt(jnp.mean(o * o, axis=-1, keepdims=True) + EPS) * g_out.astype(f32).reshape(GLA_HEADS, GLA_DV)
    y = (o.reshape(B, T, nv) * jax.nn.silu(r.astype(f32))).astype(h.dtype) @ w_out
    return y, S.astype(h.dtype)


def trunk(x, c, w_ada, b_ada, norm_g, sb_w_in, sb_w_out, gla_w_in, gla_w_a2, gla_b_a,
          gla_norm_g, gla_w_out, final_norm_g, cache_sb_k=None, cache_sb_v=None, state_gla=None):
    new_k, new_v, new_s = [], [], []
    for i in range(DEPTH):
        j = i // N_MIXERS
        shift, scale, gate = jnp.split(c @ w_ada[i] + b_ada[i], 3, axis=-1)
        h = rmsnorm(x, norm_g[i]) * (1 + scale[:, None]) + shift[:, None]
        if i % N_MIXERS == 0:
            if cache_sb_k is None:
                y, k, v = sb_mixer(h, sb_w_in[j], sb_w_out[j])
            else:
                y, k, v = sb_mixer(h, sb_w_in[j], sb_w_out[j], cache_sb_k[j], cache_sb_v[j])
            new_k.append(k)
            new_v.append(v)
        else:
            S0 = None if state_gla is None else state_gla[j]
            y, S = gla_mixer(h, gla_w_in[j], gla_w_a2[j], gla_b_a[j], gla_norm_g[j], gla_w_out[j], S0)
            new_s.append(S)
        x = x + gate[:, None] * y
    return rmsnorm(x, final_norm_g), jnp.stack(new_k), jnp.stack(new_v), jnp.stack(new_s)


def setup_inputs(seed: int = 0) -> dict:
    key = jax.random.key(seed)
    ks = jax.random.split(key, 18)
    nrm = lambda k, shape, s: jax.random.normal(k, shape, jnp.float32) * s
    D = D_MODEL
    return {
        "x_prompt": nrm(ks[0], (BATCH, SEQ, D), 1.0),
        "x_sample": nrm(ks[1], (DEC_BATCH, DEC_SEQ, D), 1.0),
        "cache_sb_k": nrm(ks[2], (N_SB_LAYERS, DEC_BATCH, PAST_LEN, SB_HEADS, SB_HEAD_DIM), 1.0),
        "cache_sb_v": nrm(ks[3], (N_SB_LAYERS, DEC_BATCH, PAST_LEN, SB_HEADS, SB_HEAD_DIM), 1.0),
        "state_gla": nrm(ks[4], (N_GLA_LAYERS, DEC_BATCH, GLA_HEADS, GLA_DK, GLA_DV), 1.0),
        "c_prompt": nrm(ks[5], (BATCH, D), 1.0),
        "c_sample": nrm(ks[6], (DEC_BATCH, D), 1.0),
        "w_ada": nrm(ks[7], (DEPTH, D, 3 * D), 0.5 * D ** -0.5),
        "b_ada": nrm(ks[8], (DEPTH, 3 * D), 0.01),
        "norm_g": 1.0 + nrm(ks[9], (DEPTH, D), 0.01),
        "sb_w_in": nrm(ks[10], (N_SB_LAYERS, D, 4 * SB_WIDTH), D ** -0.5),
        "sb_w_out": nrm(ks[11], (N_SB_LAYERS, SB_WIDTH, D), SB_WIDTH ** -0.5),
        "gla_w_in": nrm(ks[12], (N_GLA_LAYERS, D, GLA_IN), D ** -0.5),
        "gla_w_a2": nrm(ks[13], (N_GLA_LAYERS, GLA_GATE_RANK, GLA_HEADS * GLA_DK), GLA_GATE_RANK ** -0.5),
        "gla_b_a": nrm(ks[14], (N_GLA_LAYERS, GLA_HEADS * GLA_DK), 0.1),
        "gla_norm_g": 1.0 + nrm(ks[15], (N_GLA_LAYERS, GLA_HEADS * GLA_DV), 0.01),
        "gla_w_out": nrm(ks[16], (N_GLA_LAYERS, GLA_HEADS * GLA_DV, D), (GLA_HEADS * GLA_DV) ** -0.5),
        "final_norm_g": 1.0 + nrm(ks[17], (D,), 0.01),
    }


def reference(x_prompt, x_sample, cache_sb_k, cache_sb_v, state_gla, c_prompt, c_sample,
              w_ada, b_ada, norm_g, sb_w_in, sb_w_out, gla_w_in, gla_w_a2, gla_b_a,
              gla_norm_g, gla_w_out, final_norm_g):
    weights = (w_ada, b_ada, norm_g, sb_w_in, sb_w_out, gla_w_in, gla_w_a2, gla_b_a,
               gla_norm_g, gla_w_out, final_norm_g)
    y_prompt, k_prompt, v_prompt, s_prompt = trunk(x_prompt, c_prompt, *weights)
    y_sample, k_sample, v_sample, s_sample = trunk(x_sample, c_sample, *weights,
                                                   cache_sb_k, cache_sb_v, state_gla)
    return (y_prompt, y_sample, k_prompt, v_prompt, k_sample, v_sample, s_prompt, s_sample)
```

```cpp
#include <hip/hip_runtime.h>
#include <cstdio>
#include <cstdint>

#ifndef LAST_PHASE
#define LAST_PHASE 99
#endif

constexpr int D = 2048;
constexpr int MP = 32768;
constexpr int MS = 128;
constexpr int MV = MP + MS;
constexpr int MT = 33024;
constexpr int SEQ = 4096, DSEQ = 16, PAST = 4096;
constexpr int NH = 16, DH = 128;
constexpr int GH = 4, GDK = 256, GDV = 512, GIN = 6160;
constexpr float EPS = 1e-6f;

constexpr size_t OY = 0;
constexpr size_t OKP = (size_t)MP * D + (size_t)MS * D;
constexpr size_t OVP = OKP + (size_t)MP * D;
constexpr size_t OKS = OVP + (size_t)MP * D;
constexpr size_t OVS = OKS + (size_t)MS * D;
constexpr size_t OSP = OVS + (size_t)MS * D;
constexpr size_t OSS = OSP + (size_t)8 * GH * GDK * GDV;
constexpr size_t OUT_TOTAL = OSS + (size_t)8 * GH * GDK * GDV;

constexpr size_t MiB = 1u << 20;
constexpr size_t WS_CTL = 0, CTL_ZERO_BYTES = 64 * 1024;
constexpr size_t WS_ADA = 1 * MiB;
constexpr size_t WS_WA = 2 * MiB;
constexpr size_t WS_W1T = 4 * MiB;
constexpr size_t WS_W2T = 36 * MiB;
constexpr size_t WS_W3T = 44 * MiB;
constexpr size_t WS_W4T = 68 * MiB;
constexpr size_t WS_EB = 76 * MiB;
constexpr size_t WS_SSQ = 80 * MiB;
constexpr size_t WS_AM = 86 * MiB;
constexpr size_t WS_R0 = 104 * MiB;
constexpr size_t RSZ = 129 * MiB;
constexpr size_t WS_KLT = WS_R0 + 6 * RSZ;
constexpr size_t WS_END = WS_KLT + 65 * MiB;
static_assert((size_t)MT * D * 2 == RSZ, "region size");
constexpr int CW_BAR = 1024;

#define LAS __attribute__((address_space(3)))
typedef unsigned short bf16;
typedef short bf16x8 __attribute__((ext_vector_type(8)));
typedef short s16x4 __attribute__((ext_vector_type(4)));
typedef float f32x2 __attribute__((ext_vector_type(2)));
typedef float f32x4 __attribute__((ext_vector_type(4)));
typedef float f32x16 __attribute__((ext_vector_type(16)));
typedef unsigned u32x2 __attribute__((ext_vector_type(2)));
typedef unsigned u32x4 __attribute__((ext_vector_type(4)));
typedef __bf16 bf16x2_t __attribute__((ext_vector_type(2)));
#define LDS_WAIT() asm volatile("s_waitcnt lgkmcnt(0)" ::: "memory")
#define DI __device__ __forceinline__

DI unsigned pk2(float lo, float hi) { f32x2 v = {lo, hi}; bf16x2_t b = __builtin_convertvector(v, bf16x2_t); return __builtin_bit_cast(unsigned, b); }
DI float bf2f(unsigned short b) { return __uint_as_float(((unsigned)b) << 16); }
DI float bflo(unsigned w) { return __uint_as_float(w << 16); }
DI float bfhi(unsigned w) { return __uint_as_float(w & 0xffff0000u); }
DI float wave_sum(float v) {
#pragma unroll
    for (int o = 1; o < 64; o <<= 1) v += __shfl_xor(v, o);
    return v;
}
DI float silu_f(float x) { return x / (1.0f + __expf(-x)); }

#define XB_TMO      128
#define XB_XCNT(j)  (256  + 64 * (j))
#define XB_XSUB(j)  (1280 + 64 * (j))
#define XB_XGEN(j)  (2304 + 64 * (j))
#define XB_TOP      3328
#define XB_TOPGEN   3392
#define XCD_BAR_WORDS 3456
#define XB_SPIN_CAP (1u << 22)

DI unsigned xb_ld(unsigned* p)              { return __hip_atomic_load(p, __ATOMIC_RELAXED, __HIP_MEMORY_SCOPE_AGENT); }
DI unsigned xb_add(unsigned* p, unsigned v) { return __hip_atomic_fetch_add(p, v, __ATOMIC_RELAXED, __HIP_MEMORY_SCOPE_AGENT); }
DI unsigned xb_xcc_id() { return (unsigned)__builtin_amdgcn_s_getreg((3 << 11) | 20) & 0xFu; }
#define XB_SPIN(cond, bar) do { unsigned _sp = 0; while (cond) { __builtin_amdgcn_s_sleep(1); \
    if ((++_sp & 255u) == 0u) { if (xb_ld(&(bar)[XB_TMO])) break; if (_sp > XB_SPIN_CAP) { atomicAdd(&(bar)[XB_TMO], 1u); break; } } } } while (0)

struct XcdBarrier { unsigned* bar; unsigned x; volatile LAS unsigned* st; };

DI XcdBarrier xcd_barrier_post(unsigned* bar, volatile LAS unsigned* st) {
    XcdBarrier b; b.bar = bar; b.x = xb_xcc_id(); b.st = st;
    if (threadIdx.x == 0) (void)xb_add(&bar[XB_XCNT(b.x)], 1u);
    return b;
}
DI void xcd_barrier_complete(unsigned* bar, unsigned x, unsigned& nloc, unsigned& nx) {
    const unsigned G = gridDim.x * gridDim.y * gridDim.z;
    unsigned sum, cnt, mine, sp = 0u;
    for (;;) {
        sum = 0u; cnt = 0u; mine = 0u;
#pragma unroll
        for (unsigned j = 0; j < 16; ++j) { const unsigned c = xb_ld(&bar[XB_XCNT(j)]); sum += c; cnt += (c > 0u) ? 1u : 0u; mine = (j == x) ? c : mine; }
        if (sum == G) break;
        __builtin_amdgcn_s_sleep(1);
        if ((++sp & 255u) == 0u) { if (xb_ld(&bar[XB_TMO])) break; if (sp > XB_SPIN_CAP) { atomicAdd(&bar[XB_TMO], 1u); break; } }
    }
    nloc = mine > 0u ? mine : 1u; nx = cnt > 0u ? cnt : 1u;
}
DI void xcd_barrier(const XcdBarrier& b) {
    asm volatile("s_waitcnt vmcnt(0)" ::: "memory");
    __syncthreads();
    if (threadIdx.x == 0) {
        unsigned* bar = b.bar;
        __builtin_amdgcn_s_waitcnt(0);
        unsigned nloc = b.st[0], nx = b.st[1];
        if (nloc == 0u) { xcd_barrier_complete(bar, b.x, nloc, nx); b.st[0] = nloc; b.st[1] = nx; }
        const unsigned old = xb_add(&bar[XB_XSUB(b.x)], 1u);
        const unsigned gen = old / nloc;
        if (old + 1u == (gen + 1u) * nloc) {
            __builtin_amdgcn_fence(__ATOMIC_RELEASE, "agent");
            asm volatile("s_waitcnt vmcnt(0)" ::: "memory");
            const unsigned og = xb_add(&bar[XB_TOP], 1u);
            const unsigned tg = og / nx;
            if (og + 1u == (tg + 1u) * nx) xb_add(&bar[XB_TOPGEN], 1u);
            else XB_SPIN(xb_ld(&bar[XB_TOPGEN]) == tg, bar);
            __builtin_amdgcn_fence(__ATOMIC_ACQUIRE, "agent");
            xb_add(&bar[XB_XGEN(b.x)], 1u);
            asm volatile("s_waitcnt vmcnt(0)" ::: "memory");
        } else {
            XB_SPIN(xb_ld(&bar[XB_XGEN(b.x)]) == gen, bar);
            __builtin_amdgcn_fence(__ATOMIC_ACQUIRE, "agent");
            asm volatile("s_waitcnt vmcnt(0)" ::: "memory");
        }
    }
    __syncthreads();
}

namespace pg8 {
#define PG8_LAS __attribute__((address_space(3)))
constexpr int BM = 256, BK = 64, HALF = 128, HTB = HALF * BK * 2, STAGE_BYTES = 8 * HTB, NXCD = 8, WGM = 8;
__host__ __device__ __forceinline__ int lds_byte(int r, int c) { const int st = (r >> 4) * 2 + (c >> 5), rr = r & 15, cc = c & 31, ob = rr * 64 + cc * 2; return st * 1024 + (ob ^ (((ob >> 9) & 1) << 5)); }
__host__ __device__ __forceinline__ void stage_rc(int b, int& R, int& C) { const int st = b / 1024, sb = b % 1024, swz = sb ^ (((sb >> 9) & 1) << 5); R = (st >> 1) * 16 + swz / 64; C = (st & 1) * 32 + (swz % 64) / 2; }
__host__ __device__ __forceinline__ int perm32(int rho) { const int n = rho >> 4, i = rho & 15; return 8 * (i >> 2) + 4 * n + (i & 3); }
struct Unit { int pm, pn; };
struct Gemm { const bf16* A; const bf16* Bt; int M, N, K; };
struct StaticOrder {
    int nM, nN, nwg, G, c;
    __host__ __device__ void init(int M, int N, int G_, int c_) { nM = M / BM; nN = N / BM; nwg = nM * nN; G = G_; c = c_; }
    __host__ __device__ bool next(int i, Unit& u) const {
        const long L = (long)i * G + c; if (L >= nwg) return false;
        int wgid = (int)L; { const int q = nwg / NXCD, r = nwg % NXCD, xcd = wgid % NXCD, off = wgid / NXCD; wgid = (xcd < r ? xcd * (q + 1) : r * (q + 1) + (xcd - r) * q) + off; }
        const int nig = WGM * nN, gid = wgid / nig, fm = gid * WGM, gsz = (nM - fm) < WGM ? (nM - fm) : WGM;
        u.pm = fm + ((wgid % nig) % gsz); u.pn = (wgid % nig) / gsz; return true;
    }
    __device__ __forceinline__ void a_ready(const Unit&) const {}
    __device__ __forceinline__ void done(const Unit&) const {}
};
template <class Epi, class Sched, bool ALIGN_EPI = false, bool SP2 = false>
__device__ __forceinline__ void gemm_phase(PG8_LAS unsigned char* lds, const Gemm g, const Sched& S, const Epi& E) {
    const int tid = threadIdx.x, wid = __builtin_amdgcn_readfirstlane(tid >> 6), lane = tid & 63, wr = wid >> 2, wc = wid & 3, fr = lane & 15, fq = lane >> 4;
    const int K = g.K, nt = K / BK;
    unsigned voffA[2], voffB[2];
#pragma unroll
    for (int i = 0; i < 2; ++i) { int R, C; stage_rc(tid * 16 + i * 8192, R, C); const int Rb = Epi::PERM ? ((R & ~31) + perm32(R & 31)) : R;
        voffA[i] = (unsigned)(R * K + C) * 2u; voffB[i] = (unsigned)(Rb * K + C) * 2u; }
    const size_t kstep = (size_t)(BK * 2);
    const size_t hstep = (size_t)HALF * K * 2;
    const size_t tstep = 2 * hstep;
    const unsigned ldsw = (unsigned)wid * 1024u;
    const int aoff = lds_byte(wr * 64 + fr, fq * 8), boff = lds_byte(wc * 32 + fr, fq * 8);
#define PG8_SA(b, h) (((b) * 2 + (h)) * HTB)
#define PG8_SB(b, h) ((4 + (b) * 2 + (h)) * HTB)
#define PG8_STAGE(bufoff, gbase, voff) do { _Pragma("unroll") for (int _i = 0; _i < 2; ++_i) \
        __builtin_amdgcn_global_load_lds((const unsigned*)((const char*)(gbase) + (voff)[_i]), (PG8_LAS unsigned*)(lds + (bufoff) + ldsw + _i * 8192), 16, 0, 0); } while (0)
#define PG8_LDA(dst, b, h) do { _Pragma("unroll") for (int m = 0; m < 4; ++m) _Pragma("unroll") for (int k = 0; k < 2; ++k) dst[m][k] = *(const PG8_LAS bf16x8*)(lds + PG8_SA(b, h) + aoff + m * 2048 + k * 1024); } while (0)
#define PG8_LDB(dst, b, h) do { _Pragma("unroll") for (int n = 0; n < 2; ++n) _Pragma("unroll") for (int k = 0; k < 2; ++k) dst[n][k] = *(const PG8_LAS bf16x8*)(lds + PG8_SB(b, h) + boff + n * 2048 + k * 1024); } while (0)
#define PG8_MMA(ai, bj, At, Bt) do { __builtin_amdgcn_s_setprio(1); _Pragma("unroll") for (int m = 0; m < 4; ++m) _Pragma("unroll") for (int n = 0; n < 2; ++n) _Pragma("unroll") for (int k = 0; k < 2; ++k) \
        acc[ai][bj][m][n] = __builtin_amdgcn_mfma_f32_16x16x32_bf16(Bt[n][k], At[m][k], acc[ai][bj][m][n], 0, 0, 0); __builtin_amdgcn_s_setprio(0); } while (0)
#define PG8_WAIT_V(n) asm volatile("s_waitcnt vmcnt(" #n ")" ::: "memory")
#define PG8_WAIT_L(n) asm volatile("s_waitcnt lgkmcnt(" #n ")" ::: "memory")
#define PG8_BAR __builtin_amdgcn_s_barrier()
#define PG8_SCHED __builtin_amdgcn_sched_barrier(0)
    Unit cur, nxt; int ui = 0;
    if (!S.next(0, cur)) return;
    f32x4 acc[2][2][4][2];
#pragma unroll
    for (int a = 0; a < 2; ++a)
#pragma unroll
        for (int b = 0; b < 2; ++b)
#pragma unroll
            for (int m = 0; m < 4; ++m)
#pragma unroll
                for (int n = 0; n < 2; ++n) acc[a][b][m][n] = (f32x4){0.f, 0.f, 0.f, 0.f};
    bf16x8 At[4][2], B0[2][2], B1[2][2];
    const char* cA = (const char*)g.A + (size_t)cur.pm * tstep; const char* cB = (const char*)g.Bt + (size_t)cur.pn * tstep;
    S.a_ready(cur);
    if constexpr (SP2) {
        PG8_STAGE(PG8_SB(0, 0), cB, voffB); PG8_STAGE(PG8_SB(0, 1), cB + hstep, voffB); PG8_STAGE(PG8_SA(0, 0), cA, voffA); PG8_STAGE(PG8_SA(0, 1), cA + hstep, voffA);
        if (wr == 1) PG8_BAR;
        PG8_WAIT_V(2); PG8_BAR;
        PG8_STAGE(PG8_SB(1, 0), cB + kstep, voffB); PG8_STAGE(PG8_SA(1, 0), cA + kstep, voffA); PG8_STAGE(PG8_SB(1, 1), cB + hstep + kstep, voffB);
        PG8_WAIT_V(6); PG8_BAR;
    } else {
        PG8_STAGE(PG8_SB(0, 0), cB, voffB); PG8_STAGE(PG8_SA(0, 0), cA, voffA); PG8_STAGE(PG8_SB(0, 1), cB + hstep, voffB); PG8_STAGE(PG8_SA(0, 1), cA + hstep, voffA);
        if (wr == 1) PG8_BAR;
        PG8_WAIT_V(4); PG8_BAR;
        PG8_STAGE(PG8_SB(1, 0), cB + kstep, voffB); PG8_STAGE(PG8_SA(1, 0), cA + kstep, voffA); PG8_STAGE(PG8_SB(1, 1), cB + hstep + kstep, voffB);
        PG8_WAIT_V(6); PG8_BAR;
    }
    for (;;) {
        const bool has_next = S.next(ui + 1, nxt);
        const char* nA = has_next ? (const char*)g.A + (size_t)nxt.pm * tstep : cA; const char* nB = has_next ? (const char*)g.Bt + (size_t)nxt.pn * tstep : cB;
        for (int t = 0; t < nt; t += 2) {
            const bool last = (t == nt - 2);
            const char* a1 = cA + (size_t)(t + 1) * kstep;
            const char* a2 = last ? nA : cA + (size_t)(t + 2) * kstep; const char* b2 = last ? nB : cB + (size_t)(t + 2) * kstep;
            const char* a3 = a2 + kstep; const char* b3 = b2 + kstep;
            if (last && has_next) S.a_ready(nxt);
            if constexpr (SP2) {
            PG8_LDB(B0, 0, 0); PG8_LDB(B1, 0, 1); PG8_SCHED; PG8_LDA(At, 0, 0); PG8_STAGE(PG8_SA(1, 1), a1 + hstep, voffA);
            PG8_WAIT_V(8); PG8_WAIT_L(0); PG8_BAR; PG8_MMA(0, 0, At, B0); PG8_MMA(0, 1, At, B1); PG8_BAR; PG8_SCHED;
            PG8_LDA(At, 0, 1); PG8_STAGE(PG8_SB(0, 0), b2, voffB); PG8_STAGE(PG8_SB(0, 1), b2 + hstep, voffB); PG8_STAGE(PG8_SA(0, 0), a2, voffA);
            PG8_WAIT_V(8); PG8_WAIT_L(0); PG8_BAR; PG8_MMA(1, 0, At, B0); PG8_MMA(1, 1, At, B1); PG8_BAR; PG8_SCHED;
            PG8_LDB(B0, 1, 0); PG8_LDB(B1, 1, 1); PG8_SCHED; PG8_LDA(At, 1, 0); PG8_STAGE(PG8_SA(0, 1), a2 + hstep, voffA);
            PG8_WAIT_V(8); PG8_WAIT_L(0); PG8_BAR; PG8_MMA(0, 0, At, B0); PG8_MMA(0, 1, At, B1); PG8_BAR; PG8_SCHED;
            PG8_LDA(At, 1, 1); PG8_STAGE(PG8_SB(1, 0), b3, voffB); PG8_STAGE(PG8_SB(1, 1), b3 + hstep, voffB); PG8_STAGE(PG8_SA(1, 0), a3, voffA);
            PG8_WAIT_V(8); PG8_WAIT_L(0); PG8_BAR; PG8_MMA(1, 0, At, B0); PG8_MMA(1, 1, At, B1); PG8_BAR; PG8_SCHED;
            } else {
            PG8_LDB(B0, 0, 0); PG8_SCHED; PG8_LDA(At, 0, 0); PG8_STAGE(PG8_SA(1, 1), a1 + hstep, voffA);
            PG8_WAIT_L(8); PG8_BAR; PG8_WAIT_L(0); PG8_MMA(0, 0, At, B0); PG8_BAR; PG8_SCHED;
            PG8_LDB(B1, 0, 1); PG8_STAGE(PG8_SB(0, 0), b2, voffB);
            PG8_BAR; PG8_WAIT_L(0); PG8_MMA(0, 1, At, B1); PG8_BAR;
            PG8_LDA(At, 0, 1); PG8_STAGE(PG8_SA(0, 0), a2, voffA);
            PG8_BAR; PG8_WAIT_L(0); PG8_MMA(1, 0, At, B0); PG8_BAR; PG8_SCHED;
            PG8_STAGE(PG8_SB(0, 1), b2 + hstep, voffB);
            PG8_WAIT_V(6); PG8_BAR; PG8_MMA(1, 1, At, B1); PG8_BAR;
            PG8_LDB(B0, 1, 0); PG8_SCHED; PG8_LDA(At, 1, 0); PG8_STAGE(PG8_SA(0, 1), a2 + hstep, voffA);
            PG8_WAIT_L(8); PG8_BAR; PG8_WAIT_L(0); PG8_MMA(0, 0, At, B0); PG8_BAR; PG8_SCHED;
            PG8_LDB(B1, 1, 1); PG8_STAGE(PG8_SB(1, 0), b3, voffB);
            PG8_BAR; PG8_WAIT_L(0); PG8_MMA(0, 1, At, B1); PG8_BAR;
            PG8_LDA(At, 1, 1); PG8_STAGE(PG8_SA(1, 0), a3, voffA);
            PG8_BAR; PG8_WAIT_L(0); PG8_MMA(1, 0, At, B0); PG8_BAR; PG8_SCHED;
            PG8_STAGE(PG8_SB(1, 1), b3 + hstep, voffB);
            PG8_WAIT_V(6); PG8_BAR; PG8_MMA(1, 1, At, B1); PG8_BAR;
            }
        }
        if constexpr (ALIGN_EPI) { if (wr == 0) PG8_BAR; }
        E(acc, cur, wr, wc, fr, fq); S.done(cur);
        if (!has_next) break;
#pragma unroll
        for (int a = 0; a < 2; ++a)
#pragma unroll
            for (int b = 0; b < 2; ++b)
#pragma unroll
                for (int m = 0; m < 4; ++m)
#pragma unroll
                    for (int n = 0; n < 2; ++n) acc[a][b][m][n] = (f32x4){0.f, 0.f, 0.f, 0.f};
        cur = nxt; cA = nA; cB = nB; ++ui;
        if constexpr (ALIGN_EPI) { if (wr == 1) PG8_BAR; }
    }
    PG8_WAIT_V(0);
    if constexpr (!ALIGN_EPI) { if (wr == 0) PG8_BAR; }
    PG8_BAR;
#undef PG8_SA
#undef PG8_SB
#undef PG8_STAGE
#undef PG8_LDA
#undef PG8_LDB
#undef PG8_MMA
#undef PG8_WAIT_V
#undef PG8_WAIT_L
#undef PG8_BAR
#undef PG8_SCHED
}
}

struct Epi1 {
    static constexpr bool PERM = true;
    unsigned char* wsb; float* okp; float* oks; float* ovp; float* ovs; float qscale;
    DI void operator()(const f32x4 (&acc)[2][2][4][2], const pg8::Unit& u, int wr, int wc, int fr, int fq) const {
        const int t = u.pn >> 3, colt = (u.pn & 7) * 256;
        const int row0 = u.pm * 256 + wr * 64 + fr, col0 = colt + wc * 32 + 8 * fq;
        bf16* bo = (bf16*)(wsb + WS_R0 + (size_t)(1 + t) * RSZ);
        float* fp = t == 1 ? okp : ovp; float* fs = t == 1 ? oks : ovs;
#pragma unroll
        for (int ai = 0; ai < 2; ++ai)
#pragma unroll
            for (int m = 0; m < 4; ++m) {
                const int row = row0 + ai * 128 + m * 16;
#pragma unroll
                for (int bj = 0; bj < 2; ++bj) {
                    f32x4 v0 = acc[ai][bj][m][0], v1 = acc[ai][bj][m][1];
                    const int col = col0 + bj * 128;
                    if (t == 1 || t == 2) {
                        float* dst = nullptr;
                        if (row < MP) dst = fp + (size_t)row * D + col; else if (row < MV) dst = fs + (size_t)(row - MP) * D + col;
                        if (dst) { *(f32x4*)dst = v0; *(f32x4*)(dst + 4) = v1; }
                    }
                    if (t == 0) { v0 = v0 * qscale; v1 = v1 * qscale; }
                    if (t == 3) {
#pragma unroll
                        for (int j = 0; j < 4; ++j) { v0[j] = silu_f(v0[j]); v1[j] = silu_f(v1[j]); }
                    }
                    u32x4 w; w.x = pk2(v0[0], v0[1]); w.y = pk2(v0[2], v0[3]); w.z = pk2(v1[0], v1[1]); w.w = pk2(v1[2], v1[3]);
                    *(u32x4*)(bo + (size_t)row * D + col) = w;
                }
            }
    }
};

struct Params {
    const float* in[18];
    float* out;
    unsigned char* ws;
};

typedef const __attribute__((address_space(4))) Params CParams;

struct Frame {
    LAS unsigned char* lds;
    int tid, lane, wave, vcu, G;
};

constexpr int LDS_BYTES = 160 * 1024 - 256;
constexpr int LDS_MISC = LDS_BYTES - 64;

DI void p0_transpose_item(const float* W, int ldw, int K, bf16* WT, LAS float* scr, int kb, int nb, int lane) {
    const int k0 = 64 * kb, n0 = 32 * nb;
#pragma unroll 8
    for (int i = 0; i < 32; ++i) { const int kk = 2 * i + (lane >> 5); scr[kk * 33 + (lane & 31)] = W[(size_t)(k0 + kk) * ldw + n0 + (lane & 31)]; }
    LDS_WAIT(); asm volatile("" ::: "memory");
    const int c = lane & 7;
#pragma unroll
    for (int j = 0; j < 4; ++j) { const int n = (lane >> 3) + 8 * j; const LAS float* s = scr + (8 * c) * 33 + n;
        u32x4 o; o.x = pk2(s[0 * 33], s[1 * 33]); o.y = pk2(s[2 * 33], s[3 * 33]); o.z = pk2(s[4 * 33], s[5 * 33]); o.w = pk2(s[6 * 33], s[7 * 33]);
        *(u32x4*)(WT + (size_t)(n0 + n) * K + k0 + 8 * c) = o; }
    LDS_WAIT(); asm volatile("" ::: "memory");
}

DI void phase0(const Frame& F, CParams& P) {
    unsigned char* ws = P.ws;
    {
        LAS float* scr = (LAS float*)(F.lds + F.wave * 8704);
        const int gw = F.vcu * 8 + F.wave, NGW = F.G * 8;
        constexpr int I1 = 32 * 256, I2 = 32 * 64, I3 = 32 * 192, I4 = 32 * 64;
        for (int it = gw; it < I1 + I2 + I3 + I4; it += NGW) {
            int r = it;
            if (r < I1) { p0_transpose_item(P.in[10], 8192, D, (bf16*)(ws + WS_W1T), scr, r / 256, r % 256, F.lane); continue; } r -= I1;
            if (r < I2) { p0_transpose_item(P.in[11], 2048, D, (bf16*)(ws + WS_W2T), scr, r / 64, r % 64, F.lane); continue; } r -= I2;
            if (r < I3) { p0_transpose_item(P.in[12], GIN, D, (bf16*)(ws + WS_W3T), scr, r / 192, r % 192, F.lane); continue; } r -= I3;
            p0_transpose_item(P.in[16], 2048, D, (bf16*)(ws + WS_W4T), scr, r / 64, r % 64, F.lane);
        }
        bf16* WA = (bf16*)(ws + WS_WA);
        for (int idx = blockIdx.x * 512 + F.tid; idx < 16 * 2048; idx += F.G * 512) { const int r = idx >> 11, k = idx & 2047; WA[idx] = (bf16)(pk2(P.in[12][(size_t)k * GIN + 6144 + r], 0.f) & 0xffffu); }
    }
    __syncthreads();
    if (blockIdx.x < 192) {
        LAS float* cs = (LAS float*)F.lds;
        for (int idx = F.tid; idx < 16 * 2048; idx += 512) { const int bi = idx >> 11, k = idx & 2047; cs[k * 16 + bi] = bi < 8 ? P.in[5][bi * 2048 + k] : P.in[6][(bi - 8) * 2048 + k]; }
        __syncthreads();
        const int l = blockIdx.x / 96, grp = blockIdx.x % 96, n = grp * 64 + F.lane;
        const float* w = P.in[7] + (size_t)l * 2048 * 6144 + n;
        float acc[16];
#pragma unroll
        for (int i = 0; i < 16; ++i) acc[i] = 0.f;
        const int kbeg = F.wave * 256;
#pragma unroll 8
        for (int k = kbeg; k < kbeg + 256; ++k) {
            const float wv = w[(size_t)k * 6144];
#pragma unroll
            for (int j = 0; j < 4; ++j) { const f32x4 cv = *(const LAS f32x4*)(cs + k * 16 + 4 * j);
                acc[4 * j + 0] += cv[0] * wv; acc[4 * j + 1] += cv[1] * wv; acc[4 * j + 2] += cv[2] * wv; acc[4 * j + 3] += cv[3] * wv; }
        }
        __syncthreads();
        LAS float* red = (LAS float*)F.lds;
#pragma unroll
        for (int i = 0; i < 16; ++i) red[(F.wave * 16 + i) * 64 + F.lane] = acc[i];
        __syncthreads();
        float* ADA = (float*)(ws + WS_ADA);
        for (int o = F.tid; o < 1024; o += 512) { const int bi = o >> 6, ln = o & 63; float s = P.in[8][l * 6144 + grp * 64 + ln];
#pragma unroll
            for (int wv = 0; wv < 8; ++wv) s += red[(wv * 16 + bi) * 64 + ln];
            ADA[(size_t)(l * 16 + bi) * 6144 + grp * 64 + ln] = s; }
    }
}

DI void phase_norm_mod(const Frame& F, CParams& P, int l, bf16* H) {
    const int gw = F.vcu * 8 + F.wave, NGW = F.G * 8;
    const float* ADA = (const float*)(P.ws + WS_ADA) + (size_t)l * 16 * 6144;
    const float* ng = P.in[9] + l * D;
    for (int m = gw; m < MT; m += NGW) {
        u32x2* o8 = (u32x2*)(H + (size_t)m * D) + F.lane;
        if (m >= MV) {
#pragma unroll
            for (int j = 0; j < 8; ++j) o8[64 * j] = (u32x2){0u, 0u};
            continue;
        }
        const float* xrow = l == 0 ? (m < MP ? P.in[0] + (size_t)m * D : P.in[1] + (size_t)(m - MP) * D) : P.out + OY + (size_t)m * D;
        const int ai = m < MP ? (m >> 12) : 8 + ((m - MP) >> 4);
        const float* sh = ADA + (size_t)ai * 6144, *sc = sh + 2048;
        const f32x4* xr = (const f32x4*)xrow + F.lane;
        f32x4 v[8]; float s = 0.f;
#pragma unroll
        for (int j = 0; j < 8; ++j) { v[j] = xr[64 * j]; s += (v[j].x * v[j].x + v[j].y * v[j].y) + (v[j].z * v[j].z + v[j].w * v[j].w); }
        const float rstd = 1.0f / sqrtf(wave_sum(s) * (1.0f / D) + EPS);
#pragma unroll
        for (int j = 0; j < 8; ++j) {
            const int c = 4 * F.lane + 256 * j;
            const f32x4 gg = *(const f32x4*)(ng + c), s1 = *(const f32x4*)(sc + c), s0 = *(const f32x4*)(sh + c);
            const f32x4 y = (v[j] * rstd) * gg * (s1 + 1.0f) + s0;
            o8[64 * j] = (u32x2){pk2(y.x, y.y), pk2(y.z, y.w)};
        }
    }
}

struct Epi3 {
    static constexpr bool PERM = true;
    unsigned char* wsb;
    DI void operator()(const f32x4 (&acc)[2][2][4][2], const pg8::Unit& u, int wr, int wc, int fr, int fq) const {
        const int t = u.pn >> 3, colt = (u.pn & 7) * 256;
        const int row0 = u.pm * 256 + wr * 64 + fr, col0 = colt + wc * 32 + 8 * fq;
        bf16* bo = (bf16*)(wsb + WS_R0 + (size_t)(t == 0 ? 1 : 3 + t) * RSZ);
#pragma unroll
        for (int ai = 0; ai < 2; ++ai)
#pragma unroll
            for (int m = 0; m < 4; ++m) {
                const int row = row0 + ai * 128 + m * 16;
#pragma unroll
                for (int bj = 0; bj < 2; ++bj) {
                    f32x4 v0 = acc[ai][bj][m][0], v1 = acc[ai][bj][m][1];
                    const int col = col0 + bj * 128;
                    if (t == 2) {
#pragma unroll
                        for (int j = 0; j < 4; ++j) { v0[j] = silu_f(v0[j]); v1[j] = silu_f(v1[j]); }
                    }
                    u32x4 w; w.x = pk2(v0[0], v0[1]); w.y = pk2(v0[2], v0[3]); w.z = pk2(v1[0], v1[1]); w.w = pk2(v1[2], v1[3]);
                    *(u32x4*)(bo + (size_t)row * D + col) = w;
                }
            }
    }
};
struct EpiRes {
    static constexpr bool PERM = false;
    const float* xp; const float* xs; float* out; const float* gate;
    DI void operator()(const f32x4 (&acc)[2][2][4][2], const pg8::Unit& u, int wr, int wc, int fr, int fq) const {
        const int row0 = u.pm * 256 + wr * 64 + fr, col0 = u.pn * 256 + wc * 32 + 4 * fq;
#pragma unroll
        for (int ai = 0; ai < 2; ++ai)
#pragma unroll
            for (int m = 0; m < 4; ++m) {
                const int row = row0 + ai * 128 + m * 16;
                if (row < MV) {
                    const float* xin = row < MP ? xp + (size_t)row * D : xs + (size_t)(row - MP) * D;
                    const int aidx = row < MP ? (row >> 12) : 8 + ((row - MP) >> 4);
                    const float* gp = gate + (size_t)aidx * 6144; float* o = out + (size_t)row * D;
#pragma unroll
                    for (int bj = 0; bj < 2; ++bj)
#pragma unroll
                        for (int n = 0; n < 2; ++n) { const int col = col0 + bj * 128 + n * 16;
                            const f32x4 xv = *(const f32x4*)(xin + col), gv = *(const f32x4*)(gp + col);
                            *(f32x4*)(o + col) = xv + gv * acc[ai][bj][m][n]; }
                }
            }
    }
};

constexpr int AT_KP = 272, AT_VP = 136;
constexpr int AT_K = 0, AT_V = 64 * AT_KP, AT_FLAG = AT_V + 128 * AT_VP;
constexpr float AT_DONE = 151.0f;
DI int crow16(int i, int hh) { return (i & 3) + 8 * (i >> 2) + 4 * hh; }

DI void attn_load_tile(const Frame& F, bool bfsrc, bool lim16, size_t rowbase, int h, const bf16* Kb, const bf16* Vb, const float* cK, const float* cV) {
    LAS unsigned char* lds = F.lds;
#pragma unroll
    for (int i = 0; i < 2; ++i) {
        const int c = F.tid + 512 * i;
        {
            const int key = c >> 4, ch = c & 15;
            u32x4 v = {0u, 0u, 0u, 0u};
            if (bfsrc) { if (!lim16 || key < 16) v = *(const u32x4*)(Kb + (rowbase + key) * D + h * 128 + ch * 8); }
            else { const float* p = cK + (rowbase + key) * D + h * 128 + ch * 8; const f32x4 a = *(const f32x4*)p, b2 = *(const f32x4*)(p + 4);
                   v.x = pk2(a[0], a[1]); v.y = pk2(a[2], a[3]); v.z = pk2(b2[0], b2[1]); v.w = pk2(b2[2], b2[3]); }
            *(LAS u32x4*)(lds + AT_K + key * AT_KP + ch * 16) = v;
        }
        {
            const int key = c & 63, dch = c >> 6;
            u32x4 v = {0u, 0u, 0u, 0u};
            if (bfsrc) { if (!lim16 || key < 16) v = *(const u32x4*)(Vb + (rowbase + key) * D + h * 128 + dch * 8); }
            else { const float* p = cV + (rowbase + key) * D + h * 128 + dch * 8; const f32x4 a = *(const f32x4*)p, b2 = *(const f32x4*)(p + 4);
                   v.x = pk2(a[0], a[1]); v.y = pk2(a[2], a[3]); v.z = pk2(b2[0], b2[1]); v.w = pk2(b2[2], b2[3]); }
            LAS unsigned short* vt = (LAS unsigned short*)(lds + AT_V + (dch * 8) * AT_VP + key * 2);
            vt[0 * (AT_VP / 2)] = (unsigned short)(v.x & 0xffffu); vt[1 * (AT_VP / 2)] = (unsigned short)(v.x >> 16);
            vt[2 * (AT_VP / 2)] = (unsigned short)(v.y & 0xffffu); vt[3 * (AT_VP / 2)] = (unsigned short)(v.y >> 16);
            vt[4 * (AT_VP / 2)] = (unsigned short)(v.z & 0xffffu); vt[5 * (AT_VP / 2)] = (unsigned short)(v.z >> 16);
            vt[6 * (AT_VP / 2)] = (unsigned short)(v.w & 0xffffu); vt[7 * (AT_VP / 2)] = (unsigned short)(v.w >> 16);
        }
    }
}

DI void attn_unit(const Frame& F, bool sample, int b, int h, int qt, const bf16* Qb, const bf16* Kb, const bf16* Vb, const bf16* ZG, bf16* OG, const float* cK, const float* cV) {
    LAS unsigned char* lds = F.lds;
    const int lane = F.lane, r = lane & 31, hh = lane >> 5, w = F.wave;
    int qpos, qmin, qmax; size_t qrow; bool qvalid;
    if (!sample) { qmin = qt * 256 + 32 * w; qpos = qmin + r; qmax = qmin + 31; qrow = (size_t)b * SEQ + qpos; qvalid = true; }
    else { qmin = PAST; qmax = PAST + DSEQ - 1; qpos = PAST + r; qrow = (size_t)MP + b * DSEQ + r; qvalid = (w == 0) && (r < DSEQ); }
    const bool wave_active = sample ? (w == 0) : true;
    bf16x8 qf[8];
#pragma unroll
    for (int s = 0; s < 8; ++s) { qf[s] = (bf16x8){0, 0, 0, 0, 0, 0, 0, 0}; if (qvalid) qf[s] = *(const bf16x8*)(Qb + qrow * D + h * 128 + 16 * s + 8 * hh); }
    f32x16 o[4];
#pragma unroll
    for (int dt = 0; dt < 4; ++dt)
#pragma unroll
        for (int i = 0; i < 16; ++i) o[dt][i] = 0.f;
    float R = 0.f; bool done = !qvalid;
    const int ntiles = sample ? 1 + PAST / 64 : 4 * (qt + 1);
    volatile LAS unsigned* flags = (volatile LAS unsigned*)(lds + AT_FLAG);
    for (int ti = 0; ti < ntiles; ++ti) {
        int kbase;
        if (!sample) { kbase = qt * 256 + 192 - 64 * ti; attn_load_tile(F, true, false, (size_t)b * SEQ + kbase, h, Kb, Vb, cK, cV); }
        else if (ti == 0) { kbase = PAST; attn_load_tile(F, true, true, (size_t)MP + b * DSEQ, h, Kb, Vb, cK, cV); }
        else { kbase = PAST - 64 * ti; attn_load_tile(F, false, false, (size_t)b * PAST + kbase, h, Kb, Vb, cK, cV); }
        __syncthreads();
        bool wdone = __all(done);
        if (wave_active && !wdone && kbase < qmax) {
#pragma unroll
            for (int kbi = 0; kbi < 2; ++kbi) {
                const int kb = 1 - kbi, kb_base = kbase + 32 * kb;
                if (kb_base >= qmax) continue;
                const bool needmask = (kb_base + 31 >= qmin);
                f32x16 acc;
#pragma unroll
                for (int i = 0; i < 16; ++i) acc[i] = 0.f;
#pragma unroll
                for (int s = 0; s < 8; ++s) {
                    const bf16x8 a = *(const LAS bf16x8*)(lds + AT_K + (32 * kb + r) * AT_KP + (16 * s + 8 * hh) * 2);
                    acc = __builtin_amdgcn_mfma_f32_32x32x16_bf16(a, qf[s], acc, 0, 0, 0);
                }
                float sp[16];
#pragma unroll
                for (int i = 0; i < 16; ++i) {
                    const float z = acc[i];
                    const float t = __builtin_amdgcn_exp2f(-__builtin_fabsf(z));
                    float s = __builtin_fmaxf(z, 0.f) + __builtin_amdgcn_logf(1.0f + t);
                    if (needmask) { const int kpos = kb_base + crow16(i, hh); s = (kpos < qpos) ? s : 0.f; }
                    sp[i] = s;
                }
                float G[4], PG[4];
#pragma unroll
                for (int g = 0; g < 4; ++g) { G[g] = (sp[4 * g] + sp[4 * g + 1]) + (sp[4 * g + 2] + sp[4 * g + 3]); PG[g] = __shfl_xor(G[g], 32); }
                float off = R; float av[16];
#pragma unroll
                for (int g = 3; g >= 0; --g) {
                    const float og = hh ? off : off + PG[g];
                    off += G[g] + PG[g];
                    const float c3 = sp[4 * g + 3] + og, c2 = sp[4 * g + 2] + c3, c1 = sp[4 * g + 1] + c2, c0 = sp[4 * g] + c1;
                    av[4 * g + 3] = __builtin_amdgcn_exp2f(acc[4 * g + 3] - c3); av[4 * g + 2] = __builtin_amdgcn_exp2f(acc[4 * g + 2] - c2);
                    av[4 * g + 1] = __builtin_amdgcn_exp2f(acc[4 * g + 1] - c1); av[4 * g] = __builtin_amdgcn_exp2f(acc[4 * g] - c0);
                }
                R = off;
                if (needmask) {
#pragma unroll
                    for (int i = 0; i < 16; ++i) { const int kpos = kb_base + crow16(i, hh); av[i] = (kpos < qpos) ? av[i] : 0.f; }
                }
                u32x4 p0, p1;
                p0.x = pk2(av[0], av[1]); p0.y = pk2(av[2], av[3]); p0.z = pk2(av[4], av[5]); p0.w = pk2(av[6], av[7]);
                p1.x = pk2(av[8], av[9]); p1.y = pk2(av[10], av[11]); p1.z = pk2(av[12], av[13]); p1.w = pk2(av[14], av[15]);
                const bf16x8 pf0 = __builtin_bit_cast(bf16x8, p0), pf1 = __builtin_bit_cast(bf16x8, p1);
#pragma unroll
                for (int dt = 0; dt < 4; ++dt) {
                    const LAS unsigned char* vrow = lds + AT_V + (32 * dt + r) * AT_VP + (32 * kb + 4 * hh) * 2;
                    const s16x4 l0 = *(const LAS s16x4*)(vrow), h0 = *(const LAS s16x4*)(vrow + 16);
                    const s16x4 l1 = *(const LAS s16x4*)(vrow + 32), h1 = *(const LAS s16x4*)(vrow + 48);
                    const bf16x8 va0 = __builtin_shufflevector(l0, h0, 0, 1, 2, 3, 4, 5, 6, 7), va1 = __builtin_shufflevector(l1, h1, 0, 1, 2, 3, 4, 5, 6, 7);
                    o[dt] = __builtin_amdgcn_mfma_f32_32x32x16_bf16(va0, pf0, o[dt], 0, 0, 0);
                    o[dt] = __builtin_amdgcn_mfma_f32_32x32x16_bf16(va1, pf1, o[dt], 0, 0, 0);
                }
            }
            done = done || (R > AT_DONE);
            wdone = __all(done);
        }
        if (lane == 0) flags[w] = (wdone || !wave_active) ? 1u : 0u;
        __syncthreads();
        unsigned alld = 1u;
#pragma unroll
        for (int i = 0; i < 8; ++i) alld &= flags[i];
        if (alld) break;
    }
    if (qvalid) {
#pragma unroll
        for (int dt = 0; dt < 4; ++dt)
#pragma unroll
            for (int g = 0; g < 4; ++g) {
                const size_t off = qrow * D + h * 128 + 32 * dt + 8 * g + 4 * hh;
                const u32x2 z = *(const u32x2*)(ZG + off);
                u32x2 ov; ov.x = pk2(o[dt][4 * g] * bflo(z.x), o[dt][4 * g + 1] * bfhi(z.x)); ov.y = pk2(o[dt][4 * g + 2] * bflo(z.y), o[dt][4 * g + 3] * bfhi(z.y));
                *(u32x2*)(OG + off) = ov;
            }
    }
    __syncthreads();
}

DI void phase_attn(const Frame& F, CParams& P, const bf16* Qb, const bf16* Kb, const bf16* Vb, const bf16* ZG, bf16* OG) {
    const float* cK = P.in[2]; const float* cV = P.in[3];
    for (int i = 0;; ++i) {
        const int u = blockIdx.x + i * F.G;
        if (u >= 2048 + 128) break;
        if (u < 2048) {
            const int c = u & 255, rnd = u >> 8;
            const int qt = (rnd & 1) == 0 ? (c & 15) : 15 - (c & 15), bh = (c >> 4) + 16 * rnd;
            attn_unit(F, false, bh >> 4, bh & 15, qt, Qb, Kb, Vb, ZG, OG, cK, cV);
        } else {
            const int bh = u - 2048;
            attn_unit(F, true, bh >> 4, bh & 15, 0, Qb, Kb, Vb, ZG, OG, cK, cV);
        }
    }
}

constexpr int G1_P = 528;
constexpr int G1_QI = 0, G1_KD = 64 * G1_P, G1_PART = 2 * 64 * G1_P, G1_ALR = G1_PART + 32768, G1_TOT = G1_ALR + 4096;
DI void gla_prep_unit(const Frame& F, CParams& P, bool sample, int b, int c, const bf16* H1, bf16* QK) {
    LAS unsigned char* lds = F.lds;
    unsigned char* ws = P.ws;
    const int lane = F.lane, w = F.wave, i16 = lane & 15, g4 = lane >> 4;
    const size_t row0 = sample ? (size_t)MP + b * DSEQ : (size_t)b * SEQ + c * 64;
    const int nvalid = sample ? DSEQ : 64;
    const bf16* WA = (const bf16*)(ws + WS_WA);
    bf16* KLT = (bf16*)(ws + WS_KLT); bf16* AM = (bf16*)(ws + WS_AM); float* EB = (float*)(ws + WS_EB);
    {
        f32x4 acc[4];
#pragma unroll
        for (int rt = 0; rt < 4; ++rt) acc[rt] = (f32x4){0.f, 0.f, 0.f, 0.f};
#pragma unroll
        for (int ks = 0; ks < 8; ++ks) {
            const int k0 = 256 * w + 32 * ks + 8 * g4;
            const bf16x8 bfr = *(const bf16x8*)(WA + i16 * D + k0);
#pragma unroll
            for (int rt = 0; rt < 4; ++rt) { const bf16x8 afr = *(const bf16x8*)(H1 + (row0 + 16 * rt + i16) * D + k0); acc[rt] = __builtin_amdgcn_mfma_f32_16x16x32_bf16(afr, bfr, acc[rt], 0, 0, 0); }
        }
        LAS float* part = (LAS float*)(lds + G1_PART) + w * 1024;
#pragma unroll
        for (int rt = 0; rt < 4; ++rt)
#pragma unroll
            for (int e = 0; e < 4; ++e) part[(16 * rt + 4 * g4 + e) * 16 + i16] = acc[rt][e];
    }
    __syncthreads();
    {
        const LAS float* part = (const LAS float*)(lds + G1_PART); LAS float* alr = (LAS float*)(lds + G1_ALR);
        for (int o = F.tid; o < 1024; o += 512) { float s = 0.f;
#pragma unroll
            for (int wv = 0; wv < 8; ++wv) s += part[wv * 1024 + o];
            alr[o] = s; }
    }
    __syncthreads();
    const LAS float* alr = (const LAS float*)(lds + G1_ALR);
    LAS float* tot = (LAS float*)(lds + G1_TOT);
    for (int h = 0; h < GH; ++h) {
        const int dk = F.tid & 255, half = F.tid >> 8, col = h * 256 + dk;
        const int uh = sample ? 2048 + b * 4 + h : (b * 4 + h) * 64 + c;
        float wa2[16];
#pragma unroll
        for (int rr = 0; rr < 16; ++rr) wa2[rr] = P.in[13][rr * 1024 + col];
        const float ba = P.in[14][col];
        float gl[32]; float pre = 0.f;
#pragma unroll
        for (int tt = 0; tt < 32; ++tt) {
            const int t = 32 * half + tt;
            float x = ba;
#pragma unroll
            for (int j = 0; j < 4; ++j) { const f32x4 av = *(const LAS f32x4*)(alr + t * 16 + 4 * j); x += av[0] * wa2[4 * j] + av[1] * wa2[4 * j + 1] + av[2] * wa2[4 * j + 2] + av[3] * wa2[4 * j + 3]; }
            const float lsig = fminf(x, 0.f) - log1pf(expf(-fabsf(x)));
            const float gt = (t < nvalid) ? lsig * 0.0625f : 0.f;
            pre += gt; gl[tt] = pre;
        }
        tot[half * 256 + dk] = pre;
        __syncthreads();
        const float t0 = tot[dk], t1 = tot[256 + dk];
        const float boff = half ? t0 : 0.f, blast = t0 + t1;
        unsigned klw[16];
#pragma unroll
        for (int tt = 0; tt < 32; tt += 2) {
            float klv[2];
#pragma unroll
            for (int q2 = 0; q2 < 2; ++q2) {
                const int t = 32 * half + tt + q2;
                const float bt = boff + gl[tt + q2];
                float qv = 0.f, kv = 0.f;
                if (t < nvalid) { qv = bf2f(QK[(row0 + t) * D + col]); kv = bf2f(QK[(row0 + t) * D + 1024 + col]); }
                const float qi = qv * 0.0625f * expf(bt), kd = kv * expf(-bt);
                klv[q2] = kv * expf(blast - bt);
                *(LAS unsigned short*)(lds + G1_QI + t * G1_P + dk * 2) = (unsigned short)(pk2(qi, 0.f) & 0xffffu);
                *(LAS unsigned short*)(lds + G1_KD + t * G1_P + dk * 2) = (unsigned short)(pk2(kd, 0.f) & 0xffffu);
            }
            klw[tt >> 1] = pk2(klv[0], klv[1]);
        }
        {
            u32x4* dst = (u32x4*)(KLT + ((size_t)uh * 256 + dk) * 64 + 32 * half);
#pragma unroll
            for (int j = 0; j < 4; ++j) dst[j] = (u32x4){klw[4 * j], klw[4 * j + 1], klw[4 * j + 2], klw[4 * j + 3]};
        }
        if (half == 1) EB[(size_t)uh * 256 + dk] = expf(blast);
        __syncthreads();
        {
            const int ct = w >> 1;
#pragma unroll
            for (int sti = 0; sti < 2; ++sti) {
                const int st = 2 * (w & 1) + sti;
                f32x4 accA = {0.f, 0.f, 0.f, 0.f};
#pragma unroll
                for (int ks = 0; ks < 8; ++ks) {
                    const bf16x8 a = *(const LAS bf16x8*)(lds + G1_QI + (16 * ct + i16) * G1_P + (32 * ks + 8 * g4) * 2);
                    const bf16x8 bb = *(const LAS bf16x8*)(lds + G1_KD + (16 * st + i16) * G1_P + (32 * ks + 8 * g4) * 2);
                    accA = __builtin_amdgcn_mfma_f32_16x16x32_bf16(a, bb, accA, 0, 0, 0);
                }
#pragma unroll
                for (int e = 0; e < 4; ++e) { const int cc = 16 * ct + 4 * g4 + e, ss = 16 * st + i16; const float v = cc >= ss ? accA[e] : 0.f;
                    AM[((size_t)uh * 64 + cc) * 64 + ss] = (unsigned short)(pk2(v, 0.f) & 0xffffu); }
            }
        }
#pragma unroll
        for (int i = 0; i < 4; ++i) { const int cidx = F.tid + 512 * i, t = cidx >> 5, ch = cidx & 31;
            if (t < nvalid) *(u32x4*)(QK + (row0 + t) * D + h * 256 + ch * 8) = *(const LAS u32x4*)(lds + G1_QI + t * G1_P + ch * 16); }
        __syncthreads();
    }
}
DI void phase_gla_prep(const Frame& F, CParams& P, const bf16* H1, bf16* QK) {
    for (int u = blockIdx.x; u < 520; u += F.G) {
        if (u < 512) gla_prep_unit(F, P, false, u >> 6, u & 63, H1, QK);
        else gla_prep_unit(F, P, true, u - 512, 0, H1, QK);
    }
}

constexpr int G2_QP = 528, G2_TP = 144;
constexpr int G2_QI = 0, G2_KLT = 64 * G2_QP, G2_VT = G2_KLT + 256 * G2_TP, G2_AM = G2_VT + 64 * G2_TP, G2_EB = G2_AM + 64 * G2_TP, G2_OP = G2_EB + 1024, G2_OT = G2_OP + 16384, G2_END = G2_OT + 64 * 68 * 4;
DI void gla_scan_unit(const Frame& F, CParams& P, bool sample, int b, int h, int sl, const bf16* QK, const bf16* V1, bf16* Ob) {
    LAS unsigned char* lds = F.lds;
    unsigned char* ws = P.ws;
    const int lane = F.lane, w = F.wave, kh = w >> 2, dq = w & 3, i16 = lane & 15, g4 = lane >> 4, tid = F.tid;
    const bf16* KLT = (const bf16*)(ws + WS_KLT); const bf16* AM = (const bf16*)(ws + WS_AM); const float* EB = (const float*)(ws + WS_EB);
    float* SSQ = (float*)(ws + WS_SSQ);
    f32x4 S[8];
    const size_t sbase = ((size_t)(b * 4 + h) * 256 + 128 * kh + 4 * g4) * 512 + sl * 64 + 16 * dq + i16;
    if (sample) {
        const float* st = P.in[4];
#pragma unroll
        for (int j = 0; j < 8; ++j)
#pragma unroll
            for (int e = 0; e < 4; ++e) S[j][e] = st[sbase + (size_t)(16 * j + e) * 512];
    } else {
#pragma unroll
        for (int j = 0; j < 8; ++j) S[j] = (f32x4){0.f, 0.f, 0.f, 0.f};
    }
    const int nchunks = sample ? 1 : 64, nvalid = sample ? DSEQ : 64;
    for (int c = 0; c < nchunks; ++c) {
        const size_t row0 = sample ? (size_t)MP + b * DSEQ : (size_t)b * SEQ + c * 64;
        const size_t uh = sample ? 2048 + b * 4 + h : (size_t)(b * 4 + h) * 64 + c;
#pragma unroll
        for (int i = 0; i < 4; ++i) {
            const int cidx = tid + 512 * i;
            { const int t = cidx >> 5, ch = cidx & 31; u32x4 v = {0u, 0u, 0u, 0u}; if (t < nvalid) v = *(const u32x4*)(QK + (row0 + t) * D + h * 256 + ch * 8);
              *(LAS u32x4*)(lds + G2_QI + t * G2_QP + ch * 16) = v; }
            { const int dk = cidx >> 3, ch = cidx & 7; const u32x4 v = *(const u32x4*)(KLT + (uh * 256 + dk) * 64 + ch * 8);
              *(LAS u32x4*)(lds + G2_KLT + dk * G2_TP + ch * 16) = v; }
        }
        { const int t = tid & 63, dch = tid >> 6; u32x4 v = {0u, 0u, 0u, 0u}; if (t < nvalid) v = *(const u32x4*)(V1 + (row0 + t) * D + h * 512 + sl * 64 + dch * 8);
          LAS unsigned short* vt = (LAS unsigned short*)(lds + G2_VT + (dch * 8) * G2_TP + t * 2);
          vt[0 * (G2_TP / 2)] = (unsigned short)(v.x & 0xffffu); vt[1 * (G2_TP / 2)] = (unsigned short)(v.x >> 16);
          vt[2 * (G2_TP / 2)] = (unsigned short)(v.y & 0xffffu); vt[3 * (G2_TP / 2)] = (unsigned short)(v.y >> 16);
          vt[4 * (G2_TP / 2)] = (unsigned short)(v.z & 0xffffu); vt[5 * (G2_TP / 2)] = (unsigned short)(v.z >> 16);
          vt[6 * (G2_TP / 2)] = (unsigned short)(v.w & 0xffffu); vt[7 * (G2_TP / 2)] = (unsigned short)(v.w >> 16); }
        { const int cc = tid >> 3, ch = tid & 7; const u32x4 v = *(const u32x4*)(AM + (uh * 64 + cc) * 64 + ch * 8); *(LAS u32x4*)(lds + G2_AM + cc * G2_TP + ch * 16) = v; }
        if (tid < 256) *(LAS float*)(lds + G2_EB + tid * 4) = EB[uh * 256 + tid];
        __syncthreads();
        bf16x8 vb[2];
#pragma unroll
        for (int ks = 0; ks < 2; ++ks) vb[ks] = *(const LAS bf16x8*)(lds + G2_VT + (16 * dq + i16) * G2_TP + (32 * ks + 8 * g4) * 2);
        bf16x8 sbf[4];
#pragma unroll
        for (int m = 0; m < 4; ++m) { u32x4 t4; t4.x = pk2(S[2 * m][0], S[2 * m][1]); t4.y = pk2(S[2 * m][2], S[2 * m][3]); t4.z = pk2(S[2 * m + 1][0], S[2 * m + 1][1]); t4.w = pk2(S[2 * m + 1][2], S[2 * m + 1][3]);
            sbf[m] = __builtin_bit_cast(bf16x8, t4); }
        f32x4 O[4];
#pragma unroll
        for (int ct = 0; ct < 4; ++ct) {
            O[ct] = (f32x4){0.f, 0.f, 0.f, 0.f};
            const bf16x8 a = *(const LAS bf16x8*)(lds + G2_AM + (16 * ct + i16) * G2_TP + (32 * kh + 8 * g4) * 2);
            O[ct] = __builtin_amdgcn_mfma_f32_16x16x32_bf16(a, kh ? vb[1] : vb[0], O[ct], 0, 0, 0);
#pragma unroll
            for (int m = 0; m < 4; ++m) {
                const LAS unsigned char* qp = lds + G2_QI + (16 * ct + i16) * G2_QP + (128 * kh + 32 * m + 4 * g4) * 2;
                const s16x4 lo = *(const LAS s16x4*)qp, hi = *(const LAS s16x4*)(qp + 32);
                const bf16x8 qa = __builtin_shufflevector(lo, hi, 0, 1, 2, 3, 4, 5, 6, 7);
                O[ct] = __builtin_amdgcn_mfma_f32_16x16x32_bf16(qa, sbf[m], O[ct], 0, 0, 0);
            }
        }
#pragma unroll
        for (int j = 0; j < 8; ++j) {
            const f32x4 ebv = *(const LAS f32x4*)(lds + G2_EB + (128 * kh + 16 * j + 4 * g4) * 4);
            S[j] = S[j] * ebv;
#pragma unroll
            for (int ks = 0; ks < 2; ++ks) { const bf16x8 a = *(const LAS bf16x8*)(lds + G2_KLT + (128 * kh + 16 * j + i16) * G2_TP + (32 * ks + 8 * g4) * 2);
                S[j] = __builtin_amdgcn_mfma_f32_16x16x32_bf16(a, vb[ks], S[j], 0, 0, 0); }
        }
        if (kh == 1) {
#pragma unroll
            for (int ct = 0; ct < 4; ++ct) *(LAS f32x4*)(lds + G2_OP + ((dq * 4 + ct) * 64 + lane) * 16) = O[ct];
        }
        __syncthreads();
        if (kh == 0) {
#pragma unroll
            for (int ct = 0; ct < 4; ++ct) { const f32x4 o2 = *(const LAS f32x4*)(lds + G2_OP + ((dq * 4 + ct) * 64 + lane) * 16); const f32x4 ov = O[ct] + o2;
#pragma unroll
                for (int e = 0; e < 4; ++e) *(LAS float*)(lds + G2_OT + ((16 * ct + 4 * g4 + e) * 68 + 16 * dq + i16) * 4) = ov[e]; }
        }
        __syncthreads();
        {
            const int cc = tid >> 3, part = tid & 7;
            const f32x4 a = *(const LAS f32x4*)(lds + G2_OT + (cc * 68 + part * 8) * 4), b2 = *(const LAS f32x4*)(lds + G2_OT + (cc * 68 + part * 8 + 4) * 4);
            float ss = (a[0] * a[0] + a[1] * a[1]) + (a[2] * a[2] + a[3] * a[3]) + (b2[0] * b2[0] + b2[1] * b2[1]) + (b2[2] * b2[2] + b2[3] * b2[3]);
            ss += __shfl_xor(ss, 1); ss += __shfl_xor(ss, 2); ss += __shfl_xor(ss, 4);
            if (cc < nvalid) {
                u32x4 ov; ov.x = pk2(a[0], a[1]); ov.y = pk2(a[2], a[3]); ov.z = pk2(b2[0], b2[1]); ov.w = pk2(b2[2], b2[3]);
                *(u32x4*)(Ob + (row0 + cc) * D + h * 512 + sl * 64 + part * 8) = ov;
                if (part == 0) SSQ[(row0 + cc) * 32 + h * 8 + sl] = ss;
            }
        }
    }
    float* so = P.out + (sample ? OSS : OSP);
#pragma unroll
    for (int j = 0; j < 8; ++j)
#pragma unroll
        for (int e = 0; e < 4; ++e) so[sbase + (size_t)(16 * j + e) * 512] = S[j][e];
    __syncthreads();
}
DI void phase_gla_scan(const Frame& F, CParams& P, const bf16* QK, const bf16* V1, bf16* Ob) {
    for (int u = blockIdx.x; u < 512; u += F.G) {
        const int v = u & 255;
        gla_scan_unit(F, P, u >= 256, v >> 5, (v >> 3) & 3, v & 7, QK, V1, Ob);
    }
}

DI void phase_gla_gate(const Frame& F, CParams& P, bf16* Ob, const bf16* Rb) {
    const int gw = F.vcu * 8 + F.wave, NGW = F.G * 8, lane = F.lane;
    const float* SSQ = (const float*)(P.ws + WS_SSQ); const float* gn = P.in[15];
    for (int m = gw; m < MV; m += NGW) {
        float sq = lane < 32 ? SSQ[(size_t)m * 32 + lane] : 0.f;
        sq += __shfl_xor(sq, 1); sq += __shfl_xor(sq, 2); sq += __shfl_xor(sq, 4);
        const float rsv = 1.0f / sqrtf(sq * (1.0f / GDV) + EPS);
#pragma unroll
        for (int j = 0; j < 4; ++j) {
            const float rs = __shfl(rsv, 8 * j);
            const int col = 8 * lane + 512 * j;
            const u32x4 ov = *(const u32x4*)(Ob + (size_t)m * D + col), rv = *(const u32x4*)(Rb + (size_t)m * D + col);
            const f32x4 g0 = *(const f32x4*)(gn + col), g1 = *(const f32x4*)(gn + col + 4);
            u32x4 y;
            y.x = pk2(bflo(ov.x) * rs * g0[0] * bflo(rv.x), bfhi(ov.x) * rs * g0[1] * bfhi(rv.x));
            y.y = pk2(bflo(ov.y) * rs * g0[2] * bflo(rv.y), bfhi(ov.y) * rs * g0[3] * bfhi(rv.y));
            y.z = pk2(bflo(ov.z) * rs * g1[0] * bflo(rv.z), bfhi(ov.z) * rs * g1[1] * bfhi(rv.z));
            y.w = pk2(bflo(ov.w) * rs * g1[2] * bflo(rv.w), bfhi(ov.w) * rs * g1[3] * bfhi(rv.w));
            *(u32x4*)(Ob + (size_t)m * D + col) = y;
        }
    }
}

DI void phase_final_norm(const Frame& F, CParams& P) {
    const int gw = F.vcu * 8 + F.wave, NGW = F.G * 8;
    const float* fg = P.in[17];
    for (int m = gw; m < MV; m += NGW) {
        f32x4* xr = (f32x4*)(P.out + OY + (size_t)m * D) + F.lane;
        f32x4 v[8]; float s = 0.f;
#pragma unroll
        for (int j = 0; j < 8; ++j) { v[j] = xr[64 * j]; s += (v[j].x * v[j].x + v[j].y * v[j].y) + (v[j].z * v[j].z + v[j].w * v[j].w); }
        const float rstd = 1.0f / sqrtf(wave_sum(s) * (1.0f / D) + EPS);
#pragma unroll
        for (int j = 0; j < 8; ++j) { const f32x4 gg = *(const f32x4*)(fg + 4 * F.lane + 256 * j); xr[64 * j] = (v[j] * rstd) * gg; }
    }
}

__global__ void __launch_bounds__(512, 2) fwd_kernel(Params P_arg) {
    extern __shared__ __attribute__((aligned(16))) unsigned char lds_raw[];
    (void)P_arg;
    CParams& P = *(CParams*)__builtin_amdgcn_kernarg_segment_ptr();
    Frame F;
    F.lds = (LAS unsigned char*)lds_raw;
    F.tid = threadIdx.x; F.lane = F.tid & 63; F.wave = __builtin_amdgcn_readfirstlane(F.tid >> 6);
    F.G = gridDim.x; { const int bx = blockIdx.x; F.vcu = (F.G % 8 == 0) ? (bx % 8) * (F.G / 8) + bx / 8 : bx; }
    volatile LAS unsigned* MISC = (volatile LAS unsigned*)(F.lds + LDS_MISC);
    if (F.tid < 16) MISC[F.tid] = 0u;
    __syncthreads();
    XcdBarrier bar = xcd_barrier_post((unsigned*)(P.ws + WS_CTL) + CW_BAR, MISC);
#define R0 ((bf16*)(P.ws + WS_R0))
#define R1 ((bf16*)(P.ws + WS_R0 + RSZ))
#define R2 ((bf16*)(P.ws + WS_R0 + 2 * RSZ))
#define R3 ((bf16*)(P.ws + WS_R0 + 3 * RSZ))
#define R4 ((bf16*)(P.ws + WS_R0 + 4 * RSZ))
#define R5 ((bf16*)(P.ws + WS_R0 + 5 * RSZ))

    phase0(F, P);
    xcd_barrier(bar);
    phase_norm_mod(F, P, 0, R0);
    xcd_barrier(bar);
    {
        pg8::Gemm g{R0, (const bf16*)(P.ws + WS_W1T), MT, 8192, D}; pg8::StaticOrder S; S.init(MT, 8192, F.G, (int)blockIdx.x);
        Epi1 E{P.ws, P.out + OKP, P.out + OKS, P.out + OVP, P.out + OVS, 0.08838834764831845f * 1.4426950408889634f};
        pg8::gemm_phase<Epi1, pg8::StaticOrder, true, true>(F.lds, g, S, E);
    }
#if LAST_PHASE >= 3
    xcd_barrier(bar);
    phase_attn(F, P, R1, R2, R3, R4, R1);
#endif
#if LAST_PHASE >= 4
    xcd_barrier(bar);
    {
        pg8::Gemm g{R1, (const bf16*)(P.ws + WS_W2T), MT, 2048, D}; pg8::StaticOrder S; S.init(MT, 2048, F.G, (int)blockIdx.x);
        EpiRes E{P.in[0], P.in[1], P.out + OY, (const float*)(P.ws + WS_ADA) + 4096};
        pg8::gemm_phase<EpiRes, pg8::StaticOrder, true, true>(F.lds, g, S, E);
    }
#endif
#if LAST_PHASE >= 5
    xcd_barrier(bar);
    phase_norm_mod(F, P, 1, R0);
    xcd_barrier(bar);
    {
        pg8::Gemm g{R0, (const bf16*)(P.ws + WS_W3T), MT, 6144, D}; pg8::StaticOrder S; S.init(MT, 6144, F.G, (int)blockIdx.x);
        Epi3 E{P.ws};
        pg8::gemm_phase<Epi3, pg8::StaticOrder, true, true>(F.lds, g, S, E);
    }
    xcd_barrier(bar);
    phase_gla_prep(F, P, R0, R1);
    xcd_barrier(bar);
    phase_gla_scan(F, P, R1, R4, R2);
#endif
#if LAST_PHASE >= 9
    xcd_barrier(bar);
    phase_gla_gate(F, P, R2, R5);
    xcd_barrier(bar);
    {
        pg8::Gemm g{R2, (const bf16*)(P.ws + WS_W4T), MT, 2048, D}; pg8::StaticOrder S; S.init(MT, 2048, F.G, (int)blockIdx.x);
        EpiRes E{P.out + OY, P.out + OY + (size_t)MP * D, P.out + OY, (const float*)(P.ws + WS_ADA) + (size_t)16 * 6144 + 4096};
        pg8::gemm_phase<EpiRes, pg8::StaticOrder, true, true>(F.lds, g, S, E);
    }
    xcd_barrier(bar);
    phase_final_norm(F, P);
#endif
#if LAST_PHASE < 9
    {
        f32x4* o = (f32x4*)P.out; const f32x4 z = {0.f, 0.f, 0.f, 0.f};
        for (size_t i = (size_t)blockIdx.x * 512 + F.tid; i < OKP / 4; i += (size_t)F.G * 512) o[i] = z;
#if LAST_PHASE < 5
        for (size_t i = OSP / 4 + (size_t)blockIdx.x * 512 + F.tid; i < OUT_TOTAL / 4; i += (size_t)F.G * 512) o[i] = z;
#endif
    }
#endif
}

#undef R0
#undef R1
#undef R2
#undef R3
#undef R4
#undef R5
extern "C" void kernel_launch(void* const* d_in, const int* in_sizes, int n_in, void* d_out, int out_size, void* d_ws, size_t ws_size, hipStream_t stream) {
    static int grid = 0;
    if (grid == 0) {
        if (n_in != 18 || (size_t)out_size != OUT_TOTAL || ws_size < WS_END) { fprintf(stderr, "kernel_launch: unexpected shapes: n_in %d out %d ws %zu (need %zu)\n", n_in, out_size, ws_size, (size_t)WS_END); grid = -1; return; }
        int dev = 0, cus = 0, per_cu = 0;
        if (hipGetDevice(&dev) != hipSuccess || hipDeviceGetAttribute(&cus, hipDeviceAttributeMultiprocessorCount, dev) != hipSuccess) { grid = -1; return; }
        if (hipFuncSetAttribute((const void*)fwd_kernel, hipFuncAttributeMaxDynamicSharedMemorySize, LDS_BYTES) != hipSuccess) { fprintf(stderr, "kernel_launch: hipFuncSetAttribute failed\n"); grid = -1; return; }
        if (hipOccupancyMaxActiveBlocksPerMultiprocessor(&per_cu, (const void*)fwd_kernel, 512, LDS_BYTES) != hipSuccess || per_cu < 1) fprintf(stderr, "kernel_launch: occupancy query reports %d\n", per_cu);
        (void)hipGetLastError();
        grid = cus;
    }
    if (grid < 0) return;
    (void)in_sizes;
    hipMemsetAsync((char*)d_ws + WS_CTL, 0, CTL_ZERO_BYTES, stream);
    Params p{};
    for (int i = 0; i < 18; ++i) p.in[i] = (const float*)d_in[i];
    p.out = (float*)d_out; p.ws = (unsigned char*)d_ws;
    hipLaunchKernelGGL(fwd_kernel, dim3(grid), dim3(512), LDS_BYTES, stream, p);
}
```

```cpp
#include <hip/hip_runtime.h>
#include <cstdio>
#include <cstdint>

#ifndef PROBE_AMP
#define PROBE_AMP 1
#endif
#ifndef LAST_PHASE
#define LAST_PHASE 99
#endif

constexpr int D = 2048;
constexpr int MP = 32768;
constexpr int MS = 128;
constexpr int MV = MP + MS;
constexpr int MT = 33024;
constexpr int SEQ = 4096, DSEQ = 16, PAST = 4096;
constexpr int NH = 16, DH = 128;
constexpr int GH = 4, GDK = 256, GDV = 512, GIN = 6160;
constexpr float EPS = 1e-6f;

constexpr size_t OY = 0;
constexpr size_t OKP = (size_t)MP * D + (size_t)MS * D;
constexpr size_t OVP = OKP + (size_t)MP * D;
constexpr size_t OKS = OVP + (size_t)MP * D;
constexpr size_t OVS = OKS + (size_t)MS * D;
constexpr size_t OSP = OVS + (size_t)MS * D;
constexpr size_t OSS = OSP + (size_t)8 * GH * GDK * GDV;
constexpr size_t OUT_TOTAL = OSS + (size_t)8 * GH * GDK * GDV;

constexpr size_t MiB = 1u << 20;
constexpr size_t WS_CTL = 0, CTL_ZERO_BYTES = 64 * 1024;
constexpr size_t WS_ADA = 1 * MiB;
constexpr size_t WS_WA = 2 * MiB;
constexpr size_t WS_W1T = 4 * MiB;
constexpr size_t WS_W2T = 36 * MiB;
constexpr size_t WS_W3T = 44 * MiB;
constexpr size_t WS_W4T = 68 * MiB;
constexpr size_t WS_EB = 76 * MiB;
constexpr size_t WS_ALR = 79 * MiB;
constexpr size_t WS_AM = 87 * MiB;
constexpr size_t WS_R0 = 104 * MiB;
constexpr size_t RSZ = 129 * MiB;
constexpr size_t WS_KLT = WS_R0 + 6 * RSZ;
constexpr size_t WS_SS2 = WS_KLT + 65 * MiB;
constexpr size_t WS_SSQ = WS_SS2 + 5 * MiB;
constexpr size_t WS_END = WS_SSQ + 17 * MiB;
static_assert((size_t)MT * D * 2 == RSZ, "region size");
constexpr int CW_BAR = 1024;

#define LAS __attribute__((address_space(3)))
typedef unsigned short bf16;
typedef short bf16x8 __attribute__((ext_vector_type(8)));
typedef short s16x4 __attribute__((ext_vector_type(4)));
typedef float f32x2 __attribute__((ext_vector_type(2)));
typedef float f32x4 __attribute__((ext_vector_type(4)));
typedef float f32x16 __attribute__((ext_vector_type(16)));
typedef unsigned u32x2 __attribute__((ext_vector_type(2)));
typedef unsigned u32x4 __attribute__((ext_vector_type(4)));
typedef __bf16 bf16x2_t __attribute__((ext_vector_type(2)));
#define LDS_WAIT() asm volatile("s_waitcnt lgkmcnt(0)" ::: "memory")
#define DI __device__ __forceinline__
#define LDS_BARRIER() do { asm volatile("s_waitcnt lgkmcnt(0)" ::: "memory"); __builtin_amdgcn_s_barrier(); asm volatile("" ::: "memory"); } while (0)

DI unsigned pk2(float lo, float hi) { f32x2 v = {lo, hi}; bf16x2_t b = __builtin_convertvector(v, bf16x2_t); return __builtin_bit_cast(unsigned, b); }
DI float bf2f(unsigned short b) { return __uint_as_float(((unsigned)b) << 16); }
DI float bflo(unsigned w) { return __uint_as_float(w << 16); }
DI float bfhi(unsigned w) { return __uint_as_float(w & 0xffff0000u); }
DI float wave_sum(float v) {
#pragma unroll
    for (int o = 1; o < 64; o <<= 1) v += __shfl_xor(v, o);
    return v;
}
template <int CTRL> DI float dppf(float v) { return __builtin_bit_cast(float, __builtin_amdgcn_update_dpp(0, __builtin_bit_cast(int, v), CTRL, 0xF, 0xF, true)); }
DI float row16_sum(float v) {
    v += dppf<0xB1>(v); v += dppf<0x4E>(v); v += dppf<0x141>(v); v += dppf<0x140>(v); return v;
}
DI float silu_f(float x) { return x / (1.0f + __expf(-x)); }

#define XB_TMO      128
#define XB_XCNT(j)  (256  + 64 * (j))
#define XB_XSUB(j)  (1280 + 64 * (j))
#define XB_XGEN(j)  (2304 + 64 * (j))
#define XB_TOP      3328
#define XB_TOPGEN   3392
#define XCD_BAR_WORDS 3456
#define XB_SPIN_CAP (1u << 22)

DI unsigned xb_ld(unsigned* p)              { return __hip_atomic_load(p, __ATOMIC_RELAXED, __HIP_MEMORY_SCOPE_AGENT); }
DI unsigned xb_add(unsigned* p, unsigned v) { return __hip_atomic_fetch_add(p, v, __ATOMIC_RELAXED, __HIP_MEMORY_SCOPE_AGENT); }
DI unsigned xb_xcc_id() { return (unsigned)__builtin_amdgcn_s_getreg((3 << 11) | 20) & 0xFu; }
#define XB_SPIN(cond, bar) do { unsigned _sp = 0; while (cond) { __builtin_amdgcn_s_sleep(1); \
    if ((++_sp & 255u) == 0u) { if (xb_ld(&(bar)[XB_TMO])) break; if (_sp > XB_SPIN_CAP) { atomicAdd(&(bar)[XB_TMO], 1u); break; } } } } while (0)

struct XcdBarrier { unsigned* bar; unsigned x; volatile LAS unsigned* st; };

DI XcdBarrier xcd_barrier_post(unsigned* bar, volatile LAS unsigned* st) {
    XcdBarrier b; b.bar = bar; b.x = xb_xcc_id(); b.st = st;
    if (threadIdx.x == 0) (void)xb_add(&bar[XB_XCNT(b.x)], 1u);
    return b;
}
DI void xcd_barrier_complete(unsigned* bar, unsigned x, unsigned& nloc, unsigned& nx) {
    const unsigned G = gridDim.x * gridDim.y * gridDim.z;
    unsigned sum, cnt, mine, sp = 0u;
    for (;;) {
        sum = 0u; cnt = 0u; mine = 0u;
#pragma unroll
        for (unsigned j = 0; j < 16; ++j) { const unsigned c = xb_ld(&bar[XB_XCNT(j)]); sum += c; cnt += (c > 0u) ? 1u : 0u; mine = (j == x) ? c : mine; }
        if (sum == G) break;
        __builtin_amdgcn_s_sleep(1);
        if ((++sp & 255u) == 0u) { if (xb_ld(&bar[XB_TMO])) break; if (sp > XB_SPIN_CAP) { atomicAdd(&bar[XB_TMO], 1u); break; } }
    }
    nloc = mine > 0u ? mine : 1u; nx = cnt > 0u ? cnt : 1u;
}
DI void xcd_barrier(const XcdBarrier& b) {
    asm volatile("s_waitcnt vmcnt(0)" ::: "memory");
    __syncthreads();
    if (threadIdx.x == 0) {
        unsigned* bar = b.bar;
        __builtin_amdgcn_s_waitcnt(0);
        unsigned nloc = b.st[0], nx = b.st[1];
        if (nloc == 0u) { xcd_barrier_complete(bar, b.x, nloc, nx); b.st[0] = nloc; b.st[1] = nx; }
        const unsigned old = xb_add(&bar[XB_XSUB(b.x)], 1u);
        const unsigned gen = old / nloc;
        if (old + 1u == (gen + 1u) * nloc) {
            __builtin_amdgcn_fence(__ATOMIC_RELEASE, "agent");
            asm volatile("s_waitcnt vmcnt(0)" ::: "memory");
            const unsigned og = xb_add(&bar[XB_TOP], 1u);
            const unsigned tg = og / nx;
            if (og + 1u == (tg + 1u) * nx) xb_add(&bar[XB_TOPGEN], 1u);
            else XB_SPIN(xb_ld(&bar[XB_TOPGEN]) == tg, bar);
            __builtin_amdgcn_fence(__ATOMIC_ACQUIRE, "agent");
            xb_add(&bar[XB_XGEN(b.x)], 1u);
            asm volatile("s_waitcnt vmcnt(0)" ::: "memory");
        } else {
            XB_SPIN(xb_ld(&bar[XB_XGEN(b.x)]) == gen, bar);
            __builtin_amdgcn_fence(__ATOMIC_ACQUIRE, "agent");
            asm volatile("s_waitcnt vmcnt(0)" ::: "memory");
        }
    }
    __syncthreads();
}

namespace pg8 {
#define PG8_LAS __attribute__((address_space(3)))
constexpr int BM = 256, BK = 64, HALF = 128, HTB = HALF * BK * 2, STAGE_BYTES = 8 * HTB, NXCD = 8, WGM = 8;
__host__ __device__ __forceinline__ int lds_byte(int r, int c) { const int st = (r >> 4) * 2 + (c >> 5), rr = r & 15, cc = c & 31, ob = rr * 64 + cc * 2; return st * 1024 + (ob ^ (((ob >> 9) & 1) << 5)); }
__host__ __device__ __forceinline__ void stage_rc(int b, int& R, int& C) { const int st = b / 1024, sb = b % 1024, swz = sb ^ (((sb >> 9) & 1) << 5); R = (st >> 1) * 16 + swz / 64; C = (st & 1) * 32 + (swz % 64) / 2; }
__host__ __device__ __forceinline__ int perm32(int rho) { const int n = rho >> 4, i = rho & 15; return 8 * (i >> 2) + 4 * n + (i & 3); }
struct Unit { int pm, pn; };
struct Gemm { const bf16* A; const bf16* Bt; int M, N, K; };
struct StaticOrder {
    int nM, nN, nwg, G, c, wgm;
    __host__ __device__ void init(int M, int N, int G_, int c_, int wgm_ = 4) { nM = M / BM; nN = N / BM; nwg = nM * nN; G = G_; c = c_; wgm = wgm_; }
    __host__ __device__ bool next(int i, Unit& u) const {
        const long L = (long)i * G + c; if (L >= nwg) return false;
        int wgid = (int)L; { const int q = nwg / NXCD, r = nwg % NXCD, xcd = wgid % NXCD, off = wgid / NXCD; wgid = (xcd < r ? xcd * (q + 1) : r * (q + 1) + (xcd - r) * q) + off; }
        const int nig = wgm * nN, gid = wgid / nig, fm = gid * wgm, gsz = (nM - fm) < wgm ? (nM - fm) : wgm;
        u.pm = fm + ((wgid % nig) % gsz); u.pn = (wgid % nig) / gsz; return true;
    }
    __device__ __forceinline__ void a_ready(const Unit&) const {}
    __device__ __forceinline__ void done(const Unit&) const {}
};
template <class Epi, class Sched, bool ALIGN_EPI = false, bool SP2 = false>
__device__ __forceinline__ void gemm_phase(PG8_LAS unsigned char* lds, const Gemm g, const Sched& S, const Epi& E) {
    int tid = threadIdx.x; asm volatile("" : "+v"(tid));
    const int wid = __builtin_amdgcn_readfirstlane(tid >> 6), lane = tid & 63, wr = wid >> 2, wc = wid & 3, fr = lane & 15, fq = lane >> 4;
    const int K = g.K, nt = K / BK;
    unsigned voffA[2], voffB[2];
#pragma unroll
    for (int i = 0; i < 2; ++i) { int R, C; stage_rc(tid * 16 + i * 8192, R, C); const int Rb = Epi::PERM ? ((R & ~31) + perm32(R & 31)) : R;
        voffA[i] = (unsigned)(R * K + C) * 2u; voffB[i] = (unsigned)(Rb * K + C) * 2u; }
    const size_t kstep = (size_t)(BK * 2);
    const size_t hstep = (size_t)HALF * K * 2;
    const size_t tstep = 2 * hstep;
    const unsigned ldsw = (unsigned)wid * 1024u;
    const int aoff = lds_byte(wr * 64 + fr, fq * 8), boff = lds_byte(wc * 32 + fr, fq * 8);
#define PG8_SA(b, h) (((b) * 2 + (h)) * HTB)
#define PG8_SB(b, h) ((4 + (b) * 2 + (h)) * HTB)
#define PG8_STAGE(bufoff, gbase, voff) do { _Pragma("unroll") for (int _i = 0; _i < 2; ++_i) \
        __builtin_amdgcn_global_load_lds((const unsigned*)((const char*)(gbase) + (voff)[_i]), (PG8_LAS unsigned*)(lds + (bufoff) + ldsw + _i * 8192), 16, 0, 0); } while (0)
#define PG8_LDA(dst, b, h) do { _Pragma("unroll") for (int m = 0; m < 4; ++m) _Pragma("unroll") for (int k = 0; k < 2; ++k) dst[m][k] = *(const PG8_LAS bf16x8*)(lds + PG8_SA(b, h) + aoff + m * 2048 + k * 1024); } while (0)
#define PG8_LDB(dst, b, h) do { _Pragma("unroll") for (int n = 0; n < 2; ++n) _Pragma("unroll") for (int k = 0; k < 2; ++k) dst[n][k] = *(const PG8_LAS bf16x8*)(lds + PG8_SB(b, h) + boff + n * 2048 + k * 1024); } while (0)
#define PG8_MMA(ai, bj, At, Bt) do { __builtin_amdgcn_s_setprio(1); _Pragma("unroll") for (int m = 0; m < 4; ++m) _Pragma("unroll") for (int n = 0; n < 2; ++n) _Pragma("unroll") for (int k = 0; k < 2; ++k) \
        acc[ai][bj][m][n] = __builtin_amdgcn_mfma_f32_16x16x32_bf16(Bt[n][k], At[m][k], acc[ai][bj][m][n], 0, 0, 0); __builtin_amdgcn_s_setprio(0); } while (0)
#define PG8_WAIT_V(n) asm volatile("s_waitcnt vmcnt(" #n ")" ::: "memory")
#define PG8_WAIT_L(n) asm volatile("s_waitcnt lgkmcnt(" #n ")" ::: "memory")
#define PG8_BAR __builtin_amdgcn_s_barrier()
#define PG8_SCHED __builtin_amdgcn_sched_barrier(0)
    Unit cur, nxt; int ui = 0;
    if (!S.next(0, cur)) return;
    f32x4 acc[2][2][4][2];
#pragma unroll
    for (int a = 0; a < 2; ++a)
#pragma unroll
        for (int b = 0; b < 2; ++b)
#pragma unroll
            for (int m = 0; m < 4; ++m)
#pragma unroll
                for (int n = 0; n < 2; ++n) acc[a][b][m][n] = (f32x4){0.f, 0.f, 0.f, 0.f};
    bf16x8 At[4][2], B0[2][2], B1[2][2];
    const char* cA = (const char*)g.A + (size_t)cur.pm * tstep; const char* cB = (const char*)g.Bt + (size_t)cur.pn * tstep;
    S.a_ready(cur);
    if constexpr (SP2) {
        PG8_STAGE(PG8_SB(0, 0), cB, voffB); PG8_STAGE(PG8_SB(0, 1), cB + hstep, voffB); PG8_STAGE(PG8_SA(0, 0), cA, voffA); PG8_STAGE(PG8_SA(0, 1), cA + hstep, voffA);
        if (wr == 1) PG8_BAR;
        PG8_WAIT_V(2); PG8_BAR;
        PG8_STAGE(PG8_SB(1, 0), cB + kstep, voffB); PG8_STAGE(PG8_SA(1, 0), cA + kstep, voffA); PG8_STAGE(PG8_SB(1, 1), cB + hstep + kstep, voffB);
        PG8_WAIT_V(6); PG8_BAR;
    } else {
        PG8_STAGE(PG8_SB(0, 0), cB, voffB); PG8_STAGE(PG8_SA(0, 0), cA, voffA); PG8_STAGE(PG8_SB(0, 1), cB + hstep, voffB); PG8_STAGE(PG8_SA(0, 1), cA + hstep, voffA);
        if (wr == 1) PG8_BAR;
        PG8_WAIT_V(4); PG8_BAR;
        PG8_STAGE(PG8_SB(1, 0), cB + kstep, voffB); PG8_STAGE(PG8_SA(1, 0), cA + kstep, voffA); PG8_STAGE(PG8_SB(1, 1), cB + hstep + kstep, voffB);
        PG8_WAIT_V(6); PG8_BAR;
    }
    for (;;) {
        const bool has_next = S.next(ui + 1, nxt);
        const char* nA = has_next ? (const char*)g.A + (size_t)nxt.pm * tstep : cA; const char* nB = has_next ? (const char*)g.Bt + (size_t)nxt.pn * tstep : cB;
        for (int t = 0; t < nt; t += 2) {
            const bool last = (t == nt - 2);
            const char* a1 = cA + (size_t)(t + 1) * kstep;
            const char* a2 = last ? nA : cA + (size_t)(t + 2) * kstep; const char* b2 = last ? nB : cB + (size_t)(t + 2) * kstep;
            const char* a3 = a2 + kstep; const char* b3 = b2 + kstep;
            if (last && has_next) S.a_ready(nxt);
            if constexpr (SP2) {
            PG8_LDB(B0, 0, 0); PG8_LDB(B1, 0, 1); PG8_SCHED; PG8_LDA(At, 0, 0); PG8_STAGE(PG8_SA(1, 1), a1 + hstep, voffA);
            PG8_WAIT_V(8); PG8_WAIT_L(0); PG8_BAR; PG8_MMA(0, 0, At, B0); PG8_MMA(0, 1, At, B1); PG8_BAR; PG8_SCHED;
            PG8_LDA(At, 0, 1); PG8_STAGE(PG8_SB(0, 0), b2, voffB); PG8_STAGE(PG8_SB(0, 1), b2 + hstep, voffB); PG8_STAGE(PG8_SA(0, 0), a2, voffA);
            PG8_WAIT_V(8); PG8_WAIT_L(0); PG8_BAR; PG8_MMA(1, 0, At, B0); PG8_MMA(1, 1, At, B1); PG8_BAR; PG8_SCHED;
            PG8_LDB(B0, 1, 0); PG8_LDB(B1, 1, 1); PG8_SCHED; PG8_LDA(At, 1, 0); PG8_STAGE(PG8_SA(0, 1), a2 + hstep, voffA);
            PG8_WAIT_V(8); PG8_WAIT_L(0); PG8_BAR; PG8_MMA(0, 0, At, B0); PG8_MMA(0, 1, At, B1); PG8_BAR; PG8_SCHED;
            PG8_LDA(At, 1, 1); PG8_STAGE(PG8_SB(1, 0), b3, voffB); PG8_STAGE(PG8_SB(1, 1), b3 + hstep, voffB); PG8_STAGE(PG8_SA(1, 0), a3, voffA);
            PG8_WAIT_V(8); PG8_WAIT_L(0); PG8_BAR; PG8_MMA(1, 0, At, B0); PG8_MMA(1, 1, At, B1); PG8_BAR; PG8_SCHED;
            } else {
            PG8_LDB(B0, 0, 0); PG8_SCHED; PG8_LDA(At, 0, 0); PG8_STAGE(PG8_SA(1, 1), a1 + hstep, voffA);
            PG8_WAIT_L(8); PG8_BAR; PG8_WAIT_L(0); PG8_MMA(0, 0, At, B0); PG8_BAR; PG8_SCHED;
            PG8_LDB(B1, 0, 1); PG8_STAGE(PG8_SB(0, 0), b2, voffB);
            PG8_BAR; PG8_WAIT_L(0); PG8_MMA(0, 1, At, B1); PG8_BAR;
            PG8_LDA(At, 0, 1); PG8_STAGE(PG8_SA(0, 0), a2, voffA);
            PG8_BAR; PG8_WAIT_L(0); PG8_MMA(1, 0, At, B0); PG8_BAR; PG8_SCHED;
            PG8_STAGE(PG8_SB(0, 1), b2 + hstep, voffB);
            PG8_WAIT_V(6); PG8_BAR; PG8_MMA(1, 1, At, B1); PG8_BAR;
            PG8_LDB(B0, 1, 0); PG8_SCHED; PG8_LDA(At, 1, 0); PG8_STAGE(PG8_SA(0, 1), a2 + hstep, voffA);
            PG8_WAIT_L(8); PG8_BAR; PG8_WAIT_L(0); PG8_MMA(0, 0, At, B0); PG8_BAR; PG8_SCHED;
            PG8_LDB(B1, 1, 1); PG8_STAGE(PG8_SB(1, 0), b3, voffB);
            PG8_BAR; PG8_WAIT_L(0); PG8_MMA(0, 1, At, B1); PG8_BAR;
            PG8_LDA(At, 1, 1); PG8_STAGE(PG8_SA(1, 0), a3, voffA);
            PG8_BAR; PG8_WAIT_L(0); PG8_MMA(1, 0, At, B0); PG8_BAR; PG8_SCHED;
            PG8_STAGE(PG8_SB(1, 1), b3 + hstep, voffB);
            PG8_WAIT_V(6); PG8_BAR; PG8_MMA(1, 1, At, B1); PG8_BAR;
            }
        }
        if constexpr (ALIGN_EPI) { if (wr == 0) PG8_BAR; }
        E(acc, cur, wr, wc, fr, fq); S.done(cur);
        if (!has_next) break;
#pragma unroll
        for (int a = 0; a < 2; ++a)
#pragma unroll
            for (int b = 0; b < 2; ++b)
#pragma unroll
                for (int m = 0; m < 4; ++m)
#pragma unroll
                    for (int n = 0; n < 2; ++n) acc[a][b][m][n] = (f32x4){0.f, 0.f, 0.f, 0.f};
        cur = nxt; cA = nA; cB = nB; ++ui;
        if constexpr (ALIGN_EPI) { if (wr == 1) PG8_BAR; }
    }
    PG8_WAIT_V(0);
    if constexpr (!ALIGN_EPI) { if (wr == 0) PG8_BAR; }
    PG8_BAR;
#undef PG8_SA
#undef PG8_SB
#undef PG8_STAGE
#undef PG8_LDA
#undef PG8_LDB
#undef PG8_MMA
#undef PG8_WAIT_V
#undef PG8_WAIT_L
#undef PG8_BAR
#undef PG8_SCHED
}
}

struct Epi1 {
    static constexpr bool PERM = true;
    unsigned char* wsb; float qscale;
    DI void operator()(const f32x4 (&acc)[2][2][4][2], const pg8::Unit& u, int wr, int wc, int fr, int fq) const {
        const int t = u.pn >> 3, colt = (u.pn & 7) * 256;
        const int row0 = u.pm * 256 + wr * 64 + fr, col0 = colt + wc * 32 + 8 * fq;
        bf16* bo = (bf16*)(wsb + WS_R0 + (size_t)(1 + t) * RSZ);
#pragma unroll
        for (int ai = 0; ai < 2; ++ai)
#pragma unroll
            for (int m = 0; m < 4; ++m) {
                const int row = row0 + ai * 128 + m * 16;
#pragma unroll
                for (int bj = 0; bj < 2; ++bj) {
                    f32x4 v0 = acc[ai][bj][m][0], v1 = acc[ai][bj][m][1];
                    const int col = col0 + bj * 128;
                    if (t == 0) { v0 = v0 * qscale; v1 = v1 * qscale; }
                    if (t == 3) {
#pragma unroll
                        for (int j = 0; j < 4; ++j) { v0[j] = silu_f(v0[j]); v1[j] = silu_f(v1[j]); }
                    }
                    u32x4 w; w.x = pk2(v0[0], v0[1]); w.y = pk2(v0[2], v0[3]); w.z = pk2(v1[0], v1[1]); w.w = pk2(v1[2], v1[3]);
                    __builtin_nontemporal_store(w, (u32x4*)(bo + (size_t)row * D + col));
                }
            }
    }
};

struct Params {
    const float* in[18];
    float* out;
    unsigned char* ws;
};

typedef const __attribute__((address_space(4))) Params CParams;

struct Frame {
    LAS unsigned char* lds;
    int tid, lane, wave, vcu, G;
};

constexpr int LDS_BYTES = 160 * 1024 - 256;
constexpr int LDS_MISC = LDS_BYTES - 64;


template <class ME>
DI void mini_gemm(const Frame& F, const bf16* A, const bf16* Bt, const ME& E, int first, int stride, int limit) {
    LAS unsigned char* lds = F.lds;
    for (int tile = first; tile < limit; tile += stride) {
        int tid = F.tid; asm volatile("" : "+v"(tid));
        const int lane = tid & 63, i16 = lane & 15, g4 = lane >> 4, w = F.wave;
        const int rt = tile & 3, cb = tile >> 2;
        f32x4 acc[2][4];
#pragma unroll
        for (int ri = 0; ri < 2; ++ri)
#pragma unroll
            for (int ci = 0; ci < 4; ++ci) acc[ri][ci] = (f32x4){0.f, 0.f, 0.f, 0.f};
        const bf16* ap = A + (size_t)(32 * rt + i16) * D + 256 * w + 8 * g4;
        const bf16* bp = Bt + (size_t)(64 * cb + i16) * D + 256 * w + 8 * g4;
#pragma unroll
        for (int ks = 0; ks < 8; ++ks) {
            bf16x8 a[2], b[4];
#pragma unroll
            for (int ri = 0; ri < 2; ++ri) a[ri] = *(const bf16x8*)(ap + (size_t)(16 * ri) * D + 32 * ks);
#pragma unroll
            for (int ci = 0; ci < 4; ++ci) b[ci] = *(const bf16x8*)(bp + (size_t)(16 * ci) * D + 32 * ks);
#pragma unroll
            for (int ri = 0; ri < 2; ++ri)
#pragma unroll
                for (int ci = 0; ci < 4; ++ci) acc[ri][ci] = __builtin_amdgcn_mfma_f32_16x16x32_bf16(a[ri], b[ci], acc[ri][ci], 0, 0, 0);
        }
        LAS float* part = (LAS float*)lds + w * 2048;
#pragma unroll
        for (int ri = 0; ri < 2; ++ri)
#pragma unroll
            for (int ci = 0; ci < 4; ++ci)
#pragma unroll
                for (int e = 0; e < 4; ++e) part[(16 * ri + 4 * g4 + e) * 64 + 16 * ci + i16] = acc[ri][ci][e];
        LDS_BARRIER();
        {
            const int row = tid >> 4, c4 = (tid & 15) * 4;
            f32x4 v = {0.f, 0.f, 0.f, 0.f};
#pragma unroll
            for (int wv = 0; wv < 8; ++wv) v += *(const LAS f32x4*)((const LAS float*)lds + wv * 2048 + row * 64 + c4);
            E(32 * rt + row, 64 * cb + c4, cb, v);
        }
        LDS_BARRIER();
    }
}
struct Mini1 {
    unsigned char* wsb; float qscale;
    DI void operator()(int srow, int col, int cb, f32x4 v) const {
        (void)cb;
        const int t = col >> 11, c = col & 2047;
        if (t == 0) v = v * qscale;
        if (t == 3) { v[0] = silu_f(v[0]); v[1] = silu_f(v[1]); v[2] = silu_f(v[2]); v[3] = silu_f(v[3]); }
        bf16* bo = (bf16*)(wsb + WS_R0 + (size_t)(1 + t) * RSZ);
        *(u32x2*)(bo + (size_t)(MP + srow) * D + c) = (u32x2){pk2(v[0], v[1]), pk2(v[2], v[3])};
    }
};
struct Mini3 {
    unsigned char* wsb;
    DI void operator()(int srow, int col, int cb, f32x4 v) const {
        (void)cb;
        const int t = col >> 11, c = col & 2047;
        if (t == 2) { v[0] = silu_f(v[0]); v[1] = silu_f(v[1]); v[2] = silu_f(v[2]); v[3] = silu_f(v[3]); }
        bf16* bo = (bf16*)(wsb + WS_R0 + (size_t)(t == 0 ? 1 : 3 + t) * RSZ);
        *(u32x2*)(bo + (size_t)(MP + srow) * D + c) = (u32x2){pk2(v[0], v[1]), pk2(v[2], v[3])};
    }
};
template <bool XBF> struct MiniRes {
    const void* xin; bf16* out; const float* gate; float* ss2;
    DI void operator()(int srow, int col, int cb, f32x4 v) const {
        const float* gp = gate + (size_t)(8 + (srow >> 4)) * 6144;
        f32x4 x;
        if (XBF) { const u32x2 xv = *(const u32x2*)((const bf16*)xin + (size_t)srow * D + col); x = (f32x4){bflo(xv.x), bfhi(xv.x), bflo(xv.y), bfhi(xv.y)}; }
        else x = *(const f32x4*)((const float*)xin + (size_t)srow * D + col);
        const f32x4 y = x + *(const f32x4*)(gp + col) * v;
        *(u32x2*)(out + (size_t)srow * D + col) = (u32x2){pk2(y[0], y[1]), pk2(y[2], y[3])};
        const float sq = row16_sum((y[0] * y[0] + y[1] * y[1]) + (y[2] * y[2] + y[3] * y[3]));
        if ((threadIdx.x & 15) == 0) ss2[(size_t)(MP + srow) * 32 + cb] = sq;
    }
};

DI void p0_transpose_item(const float* W, int ldw, int K, bf16* WT, LAS float* scr, int kb, int nb, int lane) {
    const int k0 = 64 * kb, n0 = 32 * nb;
    float wv[32];
#pragma unroll
    for (int i = 0; i < 32; ++i) wv[i] = W[(size_t)(k0 + 2 * i + (lane >> 5)) * ldw + n0 + (lane & 31)];
#pragma unroll
    for (int i = 0; i < 32; ++i) scr[(2 * i + (lane >> 5)) * 33 + (lane & 31)] = wv[i];
    LDS_WAIT(); asm volatile("" ::: "memory");
    const int c = lane & 7;
#pragma unroll
    for (int j = 0; j < 4; ++j) { const int n = (lane >> 3) + 8 * j; const LAS float* s = scr + (8 * c) * 33 + n;
        u32x4 o; o.x = pk2(s[0 * 33], s[1 * 33]); o.y = pk2(s[2 * 33], s[3 * 33]); o.z = pk2(s[4 * 33], s[5 * 33]); o.w = pk2(s[6 * 33], s[7 * 33]);
        *(u32x4*)(WT + (size_t)(n0 + n) * K + k0 + 8 * c) = o; }
    LDS_WAIT(); asm volatile("" ::: "memory");
}

DI void phase0_transposes(const Frame& F, CParams& P) {
    unsigned char* ws = P.ws;
    {
        LAS float* scr = (LAS float*)(F.lds + F.wave * 8704);
        const int gw = F.vcu * 8 + F.wave, NGW = F.G * 8;
        constexpr int I1 = 32 * 256, I2 = 32 * 64, I3 = 32 * 192, I4 = 32 * 64;
        for (int it = gw; it < I1 + I2 + I3 + I4; it += NGW) {
            int r = it;
            if (r < I1) { p0_transpose_item(P.in[10], 8192, D, (bf16*)(ws + WS_W1T), scr, r / 256, r % 256, F.lane); continue; } r -= I1;
            if (r < I2) { p0_transpose_item(P.in[11], 2048, D, (bf16*)(ws + WS_W2T), scr, r / 64, r % 64, F.lane); continue; } r -= I2;
            if (r < I3) { p0_transpose_item(P.in[12], GIN, D, (bf16*)(ws + WS_W3T), scr, r / 192, r % 192, F.lane); continue; } r -= I3;
            p0_transpose_item(P.in[16], 2048, D, (bf16*)(ws + WS_W4T), scr, r / 64, r % 64, F.lane);
        }
        bf16* WA = (bf16*)(ws + WS_WA);
        for (int idx = blockIdx.x * 512 + F.tid; idx < 16 * 2048; idx += F.G * 512) { const int r = idx >> 11, k = idx & 2047; WA[idx] = (bf16)(pk2(P.in[12][(size_t)k * GIN + 6144 + r], 0.f) & 0xffffu); }
    }
}
DI void phase0_ada(const Frame& F, CParams& P) {
    unsigned char* ws = P.ws;
    if (blockIdx.x < 192) {
        LAS float* cs = (LAS float*)F.lds;
        for (int idx = F.tid; idx < 16 * 2048; idx += 512) { const int bi = idx >> 11, k = idx & 2047; cs[k * 16 + bi] = bi < 8 ? P.in[5][bi * 2048 + k] : P.in[6][(bi - 8) * 2048 + k]; }
        __syncthreads();
        const int l = blockIdx.x / 96, grp = blockIdx.x % 96, n = grp * 64 + F.lane;
        const float* w = P.in[7] + (size_t)l * 2048 * 6144 + n;
        float acc[16];
#pragma unroll
        for (int i = 0; i < 16; ++i) acc[i] = 0.f;
        const int kbeg = F.wave * 256;
#pragma unroll 8
        for (int k = kbeg; k < kbeg + 256; ++k) {
            const float wv = w[(size_t)k * 6144];
#pragma unroll
            for (int j = 0; j < 4; ++j) { const f32x4 cv = *(const LAS f32x4*)(cs + k * 16 + 4 * j);
                acc[4 * j + 0] += cv[0] * wv; acc[4 * j + 1] += cv[1] * wv; acc[4 * j + 2] += cv[2] * wv; acc[4 * j + 3] += cv[3] * wv; }
        }
        __syncthreads();
        LAS float* red = (LAS float*)F.lds;
#pragma unroll
        for (int i = 0; i < 16; ++i) red[(F.wave * 16 + i) * 64 + F.lane] = acc[i];
        __syncthreads();
        float* ADA = (float*)(ws + WS_ADA);
        for (int o = F.tid; o < 1024; o += 512) { const int bi = o >> 6, ln = o & 63; float s = P.in[8][l * 6144 + grp * 64 + ln];
#pragma unroll
            for (int wv = 0; wv < 8; ++wv) s += red[(wv * 16 + bi) * 64 + ln];
            ADA[(size_t)(l * 16 + bi) * 6144 + grp * 64 + ln] = s; }
    }
}

DI void phase_norm_mod_generic(const Frame& F, CParams& P, int l, bf16* H) {
    const int gw = F.vcu * 8 + F.wave, NGW = F.G * 8;
    const float* ADA = (const float*)(P.ws + WS_ADA) + (size_t)l * 16 * 6144;
    const float* ng = P.in[9] + l * D;
    for (int m = gw; m < MT; m += NGW) {
        u32x2* o8 = (u32x2*)(H + (size_t)m * D) + F.lane;
        if (m >= MV) {
#pragma unroll
            for (int j = 0; j < 8; ++j) o8[64 * j] = (u32x2){0u, 0u};
            continue;
        }
        const float* xrow = l == 0 ? (m < MP ? P.in[0] + (size_t)m * D : P.in[1] + (size_t)(m - MP) * D) : P.out + OY + (size_t)m * D;
        const int ai = m < MP ? (m >> 12) : 8 + ((m - MP) >> 4);
        const float* sh = ADA + (size_t)ai * 6144, *sc = sh + 2048;
        const f32x4* xr = (const f32x4*)xrow + F.lane;
        f32x4 v[8]; float s = 0.f;
#pragma unroll
        for (int j = 0; j < 8; ++j) { v[j] = xr[64 * j]; s += (v[j].x * v[j].x + v[j].y * v[j].y) + (v[j].z * v[j].z + v[j].w * v[j].w); }
        const float rstd = 1.0f / sqrtf(wave_sum(s) * (1.0f / D) + EPS);
#pragma unroll
        for (int j = 0; j < 8; ++j) {
            const int c = 4 * F.lane + 256 * j;
            const f32x4 gg = *(const f32x4*)(ng + c), s1 = *(const f32x4*)(sc + c), s0 = *(const f32x4*)(sh + c);
            const f32x4 y = (v[j] * rstd) * gg * (s1 + 1.0f) + s0;
            o8[64 * j] = (u32x2){pk2(y.x, y.y), pk2(y.z, y.w)};
        }
    }
}

constexpr int P1_GM = 96 * 1024, P1_SH = P1_GM + 8192;
DI void p1_tables(const Frame& F, CParams& P, int ai) {
    const float* ADA = (const float*)(P.ws + WS_ADA) + (size_t)ai * 6144;
    const float* ng = P.in[9];
    const int c = 4 * F.tid;
    const f32x4 g = *(const f32x4*)(ng + c), sc = *(const f32x4*)(ADA + 2048 + c), sh = *(const f32x4*)(ADA + c);
    *(LAS f32x4*)(F.lds + P1_GM + c * 4) = g * (sc + 1.0f); *(LAS f32x4*)(F.lds + P1_SH + c * 4) = sh;
}
DI void p1_rows(const Frame& F, const float* xbase, bf16* hbase, int nrows) {
    const int lane = F.lane;
    f32x4 vn[8];
    { const f32x4* xr = (const f32x4*)xbase + lane;
#pragma unroll
      for (int j = 0; j < 8; ++j) vn[j] = xr[64 * j]; }
    for (int i = 0; i < nrows; ++i) {
        f32x4 v[8]; float s = 0.f;
#pragma unroll
        for (int j = 0; j < 8; ++j) { v[j] = vn[j]; s += (v[j].x * v[j].x + v[j].y * v[j].y) + (v[j].z * v[j].z + v[j].w * v[j].w); }
        if (i + 1 < nrows) { const f32x4* xr = (const f32x4*)(xbase + (size_t)(i + 1) * D) + lane;
#pragma unroll
            for (int j = 0; j < 8; ++j) vn[j] = xr[64 * j]; }
        const float rstd = 1.0f / sqrtf(wave_sum(s) * (1.0f / D) + EPS);
        u32x2* o8 = (u32x2*)(hbase + (size_t)i * D) + lane;
#pragma unroll
        for (int j = 0; j < 8; ++j) {
            const int c = 4 * lane + 256 * j;
            const f32x4 gm = *(const LAS f32x4*)(F.lds + P1_GM + c * 4), s0 = *(const LAS f32x4*)(F.lds + P1_SH + c * 4);
            const f32x4 y = (v[j] * rstd) * gm + s0;
            o8[64 * j] = (u32x2){pk2(y.x, y.y), pk2(y.z, y.w)};
        }
    }
}
DI void phase_norm_mod(const Frame& F, CParams& P, int l, bf16* H) {
    if (F.G != 256 || l != 0) { phase_norm_mod_generic(F, P, l, H); return; }
    const int v = F.vcu, w = F.wave;
    p1_tables(F, P, v >> 5);
    __syncthreads();
    p1_rows(F, P.in[0] + ((size_t)128 * v + 16 * w) * D, H + ((size_t)128 * v + 16 * w) * D, 16);
    if (v < 8) {
        __syncthreads();
        p1_tables(F, P, 8 + v);
        __syncthreads();
        p1_rows(F, P.in[1] + ((size_t)16 * v + 2 * w) * D, H + ((size_t)MP + 16 * v + 2 * w) * D, 2);
    }
}

struct Epi3 {
    static constexpr bool PERM = true;
    unsigned char* wsb;
    DI void operator()(const f32x4 (&acc)[2][2][4][2], const pg8::Unit& u, int wr, int wc, int fr, int fq) const {
        const int t = u.pn >> 3, colt = (u.pn & 7) * 256;
        const int row0 = u.pm * 256 + wr * 64 + fr, col0 = colt + wc * 32 + 8 * fq;
        bf16* bo = (bf16*)(wsb + WS_R0 + (size_t)(t == 0 ? 1 : 3 + t) * RSZ);
#pragma unroll
        for (int ai = 0; ai < 2; ++ai)
#pragma unroll
            for (int m = 0; m < 4; ++m) {
                const int row = row0 + ai * 128 + m * 16;
#pragma unroll
                for (int bj = 0; bj < 2; ++bj) {
                    f32x4 v0 = acc[ai][bj][m][0], v1 = acc[ai][bj][m][1];
                    const int col = col0 + bj * 128;
                    if (t == 2) {
#pragma unroll
                        for (int j = 0; j < 4; ++j) { v0[j] = silu_f(v0[j]); v1[j] = silu_f(v1[j]); }
                    }
                    u32x4 w; w.x = pk2(v0[0], v0[1]); w.y = pk2(v0[2], v0[3]); w.z = pk2(v1[0], v1[1]); w.w = pk2(v1[2], v1[3]);
                    __builtin_nontemporal_store(w, (u32x4*)(bo + (size_t)row * D + col));
                }
            }
    }
};
template <bool XBF> struct EpiRes {
    static constexpr bool PERM = true;
    const void* xin; bf16* out; const float* gate; float* ss2;
    DI void operator()(const f32x4 (&acc)[2][2][4][2], const pg8::Unit& u, int wr, int wc, int fr, int fq) const {
        const int row0 = u.pm * 256 + wr * 64 + fr, col0 = u.pn * 256 + wc * 32 + 8 * fq;
        const float* gp = gate + (size_t)((u.pm * 256) >> 12) * 6144;
        f32x4 gv[2][2];
#pragma unroll
        for (int bj = 0; bj < 2; ++bj) { gv[bj][0] = *(const f32x4*)(gp + col0 + bj * 128); gv[bj][1] = *(const f32x4*)(gp + col0 + bj * 128 + 4); }
#pragma unroll
        for (int ai = 0; ai < 2; ++ai)
#pragma unroll
            for (int m = 0; m < 4; ++m) {
                const int row = row0 + ai * 128 + m * 16;
                float sq = 0.f;
#pragma unroll
                for (int bj = 0; bj < 2; ++bj) {
                    const int col = col0 + bj * 128;
                    f32x4 x0, x1;
                    if (XBF) { const u32x4 xv = *(const u32x4*)((const bf16*)xin + (size_t)row * D + col); x0 = (f32x4){bflo(xv.x), bfhi(xv.x), bflo(xv.y), bfhi(xv.y)}; x1 = (f32x4){bflo(xv.z), bfhi(xv.z), bflo(xv.w), bfhi(xv.w)}; }
                    else { const float* xp = (const float*)xin + (size_t)row * D + col; x0 = *(const f32x4*)xp; x1 = *(const f32x4*)(xp + 4); }
                    const f32x4 y0 = x0 + gv[bj][0] * acc[ai][bj][m][0], y1 = x1 + gv[bj][1] * acc[ai][bj][m][1];
                    sq += (y0[0] * y0[0] + y0[1] * y0[1]) + (y0[2] * y0[2] + y0[3] * y0[3]) + (y1[0] * y1[0] + y1[1] * y1[1]) + (y1[2] * y1[2] + y1[3] * y1[3]);
                    u32x4 w; w.x = pk2(y0[0], y0[1]); w.y = pk2(y0[2], y0[3]); w.z = pk2(y1[0], y1[1]); w.w = pk2(y1[2], y1[3]);
                    *(u32x4*)(out + (size_t)row * D + col) = w;
                }
                sq += __shfl_xor(sq, 16); sq += __shfl_xor(sq, 32);
                if (fq == 0) ss2[(size_t)row * 32 + u.pn * 4 + wc] = sq;
            }
    }
};

constexpr int AT_TILE = 16384;
constexpr int AT_KB0 = 0, AT_VB0 = AT_TILE, AT_SLOT = 4 * AT_TILE, AT_FLAG = 2 * AT_SLOT;
constexpr float AT_DONE = 8.673617379884035e-19f;
DI int crow16(int i, int hh) { return (i & 3) + 8 * (i >> 2) + 4 * hh; }
DI int at_fx(int row) { return ((row & 3) << 2) | ((row >> 2) & 3); }
DI int at_off(int row, int ch) { return 256 * row + 16 * (ch ^ at_fx(row)); }
typedef short v4i16_t __attribute__((ext_vector_type(4)));

DI void attn_dma_tile(LAS unsigned char* lds, int rb, int w, int lane, size_t rowbase, int h, const bf16* Kb, const bf16* Vb) {
#pragma unroll
    for (int i = 0; i < 2; ++i) {
        const int piece = 2 * w + i, row = 4 * piece + (lane >> 4), ch = (lane & 15) ^ at_fx(row);
        const size_t goff = (rowbase + row) * D + h * 128 + ch * 8;
        __builtin_amdgcn_global_load_lds((const unsigned*)(Kb + goff), (LAS unsigned*)(lds + rb * 2 * AT_TILE + AT_KB0 + piece * 1024), 16, 0, 0);
        __builtin_amdgcn_global_load_lds((const unsigned*)(Vb + goff), (LAS unsigned*)(lds + rb * 2 * AT_TILE + AT_VB0 + piece * 1024), 16, 0, 0);
    }
}
struct AtRegs { f32x4 k[4], v[4]; };
DI void attn_move_sample(LAS unsigned char* lds, int buf, int tid, size_t rowbase, int h, const float* cK, const float* cV) {
    for (int c = tid - 64; c < 1024; c += 448) {
        const int key = c >> 4, ch = c & 15;
        const float* pk = cK + (rowbase + key) * D + h * 128 + ch * 8; const float* pv = cV + (rowbase + key) * D + h * 128 + ch * 8;
        const f32x4 a = *(const f32x4*)pk, b2 = *(const f32x4*)(pk + 4), c2 = *(const f32x4*)pv, d2 = *(const f32x4*)(pv + 4);
        u32x4 kv, vv;
        kv.x = pk2(a[0], a[1]); kv.y = pk2(a[2], a[3]); kv.z = pk2(b2[0], b2[1]); kv.w = pk2(b2[2], b2[3]);
        vv.x = pk2(c2[0], c2[1]); vv.y = pk2(c2[2], c2[3]); vv.z = pk2(d2[0], d2[1]); vv.w = pk2(d2[2], d2[3]);
        *(LAS u32x4*)(lds + buf * 2 * AT_TILE + AT_KB0 + at_off(key, ch)) = kv;
        *(LAS u32x4*)(lds + buf * 2 * AT_TILE + AT_VB0 + at_off(key, ch)) = vv;
    }
}
DI void attn_fetch_sample(AtRegs& r, int tid, bool newkeys, size_t rowbase, int h, const bf16* Kb, const bf16* Vb, const float* cK, const float* cV) {
#pragma unroll
    for (int i = 0; i < 2; ++i) {
        const int c = tid + 512 * i, key = c >> 4, ch = c & 15;
        if (newkeys) {
            u32x4 kv = {0u, 0u, 0u, 0u}, vv = {0u, 0u, 0u, 0u};
            if (key < DSEQ) { kv = *(const u32x4*)(Kb + (rowbase + key) * D + h * 128 + ch * 8); vv = *(const u32x4*)(Vb + (rowbase + key) * D + h * 128 + ch * 8); }
            r.k[2 * i] = __builtin_bit_cast(f32x4, kv); r.v[2 * i] = __builtin_bit_cast(f32x4, vv);
        } else {
            const float* pk = cK + (rowbase + key) * D + h * 128 + ch * 8; const float* pv = cV + (rowbase + key) * D + h * 128 + ch * 8;
            r.k[2 * i] = *(const f32x4*)pk; r.k[2 * i + 1] = *(const f32x4*)(pk + 4); r.v[2 * i] = *(const f32x4*)pv; r.v[2 * i + 1] = *(const f32x4*)(pv + 4);
        }
    }
}
DI void attn_commit_sample(const AtRegs& r, LAS unsigned char* lds, int buf, int tid, bool newkeys) {
#pragma unroll
    for (int i = 0; i < 2; ++i) {
        const int c = tid + 512 * i, key = c >> 4, ch = c & 15;
        u32x4 kv, vv;
        if (newkeys) { kv = __builtin_bit_cast(u32x4, r.k[2 * i]); vv = __builtin_bit_cast(u32x4, r.v[2 * i]); }
        else { const f32x4 a = r.k[2 * i], b2 = r.k[2 * i + 1], c2 = r.v[2 * i], d2 = r.v[2 * i + 1];
            kv.x = pk2(a[0], a[1]); kv.y = pk2(a[2], a[3]); kv.z = pk2(b2[0], b2[1]); kv.w = pk2(b2[2], b2[3]);
            vv.x = pk2(c2[0], c2[1]); vv.y = pk2(c2[2], c2[3]); vv.z = pk2(d2[0], d2[1]); vv.w = pk2(d2[2], d2[3]); }
        *(LAS u32x4*)(lds + buf * 2 * AT_TILE + AT_KB0 + at_off(key, ch)) = kv;
        *(LAS u32x4*)(lds + buf * 2 * AT_TILE + AT_VB0 + at_off(key, ch)) = vv;
    }
}

DI void attn_kv_out(int t, int nthr, int nchunks, size_t row0, int h, const bf16* Kb, const bf16* Vb, float* ok, float* ov) {
    for (int c = t; c < nchunks; c += nthr) {
        const size_t off = (row0 + (c >> 4)) * D + h * 128 + (c & 15) * 8;
        const u32x4 kv = *(const u32x4*)(Kb + off), vv = *(const u32x4*)(Vb + off);
        __builtin_nontemporal_store((f32x4){bflo(kv.x), bfhi(kv.x), bflo(kv.y), bfhi(kv.y)}, (f32x4*)(ok + off));
        __builtin_nontemporal_store((f32x4){bflo(kv.z), bfhi(kv.z), bflo(kv.w), bfhi(kv.w)}, (f32x4*)(ok + off + 4));
        __builtin_nontemporal_store((f32x4){bflo(vv.x), bfhi(vv.x), bflo(vv.y), bfhi(vv.y)}, (f32x4*)(ov + off));
        __builtin_nontemporal_store((f32x4){bflo(vv.z), bfhi(vv.z), bflo(vv.w), bfhi(vv.w)}, (f32x4*)(ov + off + 4));
    }
}
DI void attn_prologue(const Frame& F, bool sample, int b, int h, int qt, bf16x8 (&qf)[8], const bf16* Qb, const bf16* Kb, const bf16* Vb, const float* cK, const float* cV) {
    int tid = F.tid; asm volatile("" : "+v"(tid));
    const int w = F.wave, lane = tid & 63, r0 = lane & 31, hh0 = lane >> 5;
    size_t qrow; bool qvalid;
    if (!sample) { qrow = (size_t)b * SEQ + qt * 256 + 32 * w + r0; qvalid = true; }
    else { qrow = (size_t)MP + b * DSEQ + r0; qvalid = (w == 0) && (r0 < DSEQ); }
    if (!sample) {
#pragma unroll
        for (int T = 0; T < 3; ++T) attn_dma_tile(F.lds, T, w, lane, (size_t)b * SEQ + qt * 256 + 192 - 64 * T, h, Kb, Vb);
    }
#pragma unroll
    for (int s = 0; s < 8; ++s) { qf[s] = (bf16x8){0, 0, 0, 0, 0, 0, 0, 0}; if (qvalid) qf[s] = *(const bf16x8*)(Qb + qrow * D + h * 128 + 16 * s + 8 * hh0); }
    if (sample) { AtRegs SR; attn_fetch_sample(SR, tid, true, (size_t)MP + b * DSEQ, h, Kb, Vb, cK, cV); attn_commit_sample(SR, F.lds, 0, tid, true); }
}
DI void attn_epilogue(const Frame& F, bool sample, int b, int h, int qt, f32x16 (&o)[4], const bf16* ZG, bf16* OG) {
    int ln = F.lane; asm volatile("" : "+v"(ln));
    const int w = F.wave, r0 = ln & 31, hh0 = ln >> 5;
    size_t qrow; bool qvalid;
    if (!sample) { qrow = (size_t)b * SEQ + qt * 256 + 32 * w + r0; qvalid = true; }
    else { qrow = (size_t)MP + b * DSEQ + r0; qvalid = (w == 0) && (r0 < DSEQ); }
    if (qvalid) {
#pragma unroll
        for (int dt = 0; dt < 4; ++dt)
#pragma unroll
            for (int g = 0; g < 4; ++g) {
                const size_t off = qrow * D + h * 128 + 32 * dt + 8 * g + 4 * hh0;
                const u32x2 z = *(const u32x2*)(ZG + off);
                u32x2 ov; ov.x = pk2(o[dt][4 * g] * bflo(z.x), o[dt][4 * g + 1] * bfhi(z.x)); ov.y = pk2(o[dt][4 * g + 2] * bflo(z.y), o[dt][4 * g + 3] * bfhi(z.y));
                *(u32x2*)(OG + off) = ov;
            }
    }
#pragma unroll
    for (int dt = 0; dt < 4; ++dt)
#pragma unroll
        for (int i = 0; i < 16; ++i) o[dt][i] = 0.f;
}
DI void attn_unit(const Frame& F, bool sample, int b, int h, int qt, const bf16x8 (&qf)[8], f32x16 (&o)[4], bool stores_behind, const bf16* Kb, const bf16* Vb, const float* cK, const float* cV, float* okv, unsigned long long& at_probe_acc) {
    LAS unsigned char* lds = F.lds;
#ifdef PROBE_AT
    const unsigned long long at_t_unit = __builtin_amdgcn_s_memrealtime();
#endif
    (void)at_probe_acc;
    const int w = F.wave, slot = sample ? 0 : (w >> 2), wsl = w & 3, tlag = sample ? 0 : 2 * (1 - slot);
    const int lane0 = F.lane, r0 = lane0 & 31, hh0 = lane0 >> 5;
    int qpos, qmin, qmax; size_t qrow; bool qvalid;
    if (!sample) { qmin = qt * 256 + 32 * w; qpos = qmin + r0; qmax = qmin + 31; qrow = (size_t)b * SEQ + qpos; qvalid = true; }
    else { qmin = PAST; qmax = PAST + DSEQ - 1; qpos = PAST + r0; qrow = (size_t)MP + b * DSEQ + r0; qvalid = (w == 0) && (r0 < DSEQ); }
    const bool wave_active = sample ? (w == 0) : true;
    float R = 1.0f; bool done = !qvalid;
    const int ntiles = sample ? 1 + PAST / 64 : 4 * (qt + 1);
    const int kb0 = qt * 256 + 192 - 64 * tlag;
    volatile LAS unsigned* flags = (volatile LAS unsigned*)(lds + AT_FLAG);
#ifdef PROBE_AT
    if (PROBE_AT == 2) at_probe_acc += __builtin_amdgcn_s_memrealtime() - at_t_unit;
#endif
    for (int ti = 0; ti < ntiles; ++ti) {
#ifdef PROBE_AT
        const unsigned long long ta0 = __builtin_amdgcn_s_memrealtime();
#endif
        if ((!sample && (ti == 1 || ti == 2)) || (ti == 0 && stores_behind)) asm volatile("s_waitcnt vmcnt(16) lgkmcnt(0)" ::: "memory"); else asm volatile("s_waitcnt vmcnt(0) lgkmcnt(0)" ::: "memory");
        __builtin_amdgcn_s_barrier(); asm volatile("" ::: "memory");
#ifdef PROBE_AT
        const unsigned long long ta1 = __builtin_amdgcn_s_memrealtime();
        if (PROBE_AT == 1 || PROBE_AT == 4) at_probe_acc += ta1 - ta0;
#endif
        if (ti > 0) {
            unsigned alld = 1u;
#pragma unroll
            for (int i = 0; i < 8; ++i) alld &= flags[((ti - 1) & 1) * 8 + i];
            if (alld) break;
        }
        int tid = F.tid; asm volatile("" : "+v"(tid));
        const int lane = tid & 63, r = lane & 31, hh = lane >> 5;
        const int buf = sample ? (ti & 1) : ((ti + tlag) & 3), nbuf = (ti & 1) ^ 1;
        const int kbase = sample ? (ti == 0 ? PAST : PAST - 64 * ti) : kb0 - 64 * ti;
        const bool more = ti + 1 < ntiles;
        if (more) {
            if (!sample) { const int kb3 = qt * 256 + 192 - 64 * (ti + 3); if (kb3 >= 0) attn_dma_tile(lds, (ti + 3) & 3, w, lane, (size_t)b * SEQ + kb3, h, Kb, Vb); }
            else if (w != 0) attn_move_sample(lds, nbuf, tid, (size_t)b * PAST + (PAST - 64 * (ti + 1)), h, cK, cV);
        }
        if (!sample) {
            if (ti < 2) {
                const LAS unsigned char* kt_ = lds + buf * 2 * AT_TILE + AT_KB0; const LAS unsigned char* vt_ = lds + buf * 2 * AT_TILE + AT_VB0;
                const int ts = wsl * 64 + lane;
#pragma unroll
                for (int i = 0; i < 4; ++i) {
                    const int c = ts + 256 * i, row = c >> 4, ch = c & 15, lo = at_off(row, ch);
                    const u32x4 kv = *(const LAS u32x4*)(kt_ + lo), vv = *(const LAS u32x4*)(vt_ + lo);
                    const size_t goff = ((size_t)b * SEQ + kbase + row) * D + h * 128 + ch * 8;
                    __builtin_nontemporal_store((f32x4){bflo(kv.x), bfhi(kv.x), bflo(kv.y), bfhi(kv.y)}, (f32x4*)(okv + OKP + goff));
                    __builtin_nontemporal_store((f32x4){bflo(kv.z), bfhi(kv.z), bflo(kv.w), bfhi(kv.w)}, (f32x4*)(okv + OKP + goff + 4));
                    __builtin_nontemporal_store((f32x4){bflo(vv.x), bfhi(vv.x), bflo(vv.y), bfhi(vv.y)}, (f32x4*)(okv + OVP + goff));
                    __builtin_nontemporal_store((f32x4){bflo(vv.z), bfhi(vv.z), bflo(vv.w), bfhi(vv.w)}, (f32x4*)(okv + OVP + goff + 4));
                }
            }
        }
        else if (ti == 0 && w != 0) attn_kv_out(tid - 64, 448, 256, (size_t)MP + b * DSEQ, h, Kb, Vb, okv + OKS - (size_t)MP * D, okv + OVS - (size_t)MP * D);
        if (kbase < 0) done = true;
        bool wdone = __all(done);
        if (wave_active && !wdone && kbase >= 0 && kbase < qmax) {
            const LAS unsigned char* kt = lds + buf * 2 * AT_TILE + AT_KB0;
            const LAS unsigned char* vt = lds + buf * 2 * AT_TILE + AT_VB0;
#pragma unroll
            for (int kbi = 0; kbi < 2; ++kbi) {
                const int kb = 1 - kbi, kb_base = kbase + 32 * kb;
                if (kb_base >= qmax) continue;
                const bool needmask = (kb_base + 31 >= qmin);
                f32x16 acc;
#pragma unroll
                for (int i = 0; i < 16; ++i) acc[i] = 0.f;
                {
                    const int krow = 32 * kb + r, fx = at_fx(krow);
#pragma unroll
                    for (int s = 0; s < 8; ++s) {
                        const bf16x8 a = *(const LAS bf16x8*)(kt + 256 * krow + 16 * ((2 * s + hh) ^ fx));
                        acc = __builtin_amdgcn_mfma_f32_32x32x16_bf16(a, qf[s], acc, 0, 0, 0);
                    }
                }
                float keep[16], av[16];
#pragma unroll
                for (int i = 0; i < 16; ++i) {
                    const float z = acc[i];
                    const float u = __builtin_amdgcn_exp2f(-__builtin_fabsf(z));
                    const float rr = __builtin_amdgcn_rcpf(1.0f + u);
                    const bool pos = z >= 0.f;
                    float kp = (pos ? u : 1.0f) * rr, bt = (pos ? 1.0f : u) * rr;
                    if (needmask) { const int kpos = kb_base + crow16(i, hh); const bool ok = kpos < qpos; kp = ok ? kp : 1.0f; bt = ok ? bt : 0.f; }
                    keep[i] = kp; av[i] = bt;
                }
                float GL[4], GH[4];
#pragma unroll
                for (int g = 0; g < 4; ++g) { const float gs = (keep[4 * g] * keep[4 * g + 1]) * (keep[4 * g + 2] * keep[4 * g + 3]);
                    auto sw = __builtin_amdgcn_permlane32_swap(__float_as_uint(gs), __float_as_uint(gs), false, false); GL[g] = __uint_as_float(sw[0]); GH[g] = __uint_as_float(sw[1]); }
                float off = R;
#pragma unroll
                for (int g = 3; g >= 0; --g) {
                    const float p3 = hh ? off : off * GH[g];
                    off *= GL[g] * GH[g];
                    const float p2 = p3 * keep[4 * g + 3], p1 = p2 * keep[4 * g + 2], p0_ = p1 * keep[4 * g + 1];
                    av[4 * g + 3] *= p3; av[4 * g + 2] *= p2; av[4 * g + 1] *= p1; av[4 * g] *= p0_;
                }
                R = off;
                u32x4 p0, p1;
                p0.x = pk2(av[0], av[1]); p0.y = pk2(av[2], av[3]); p0.z = pk2(av[4], av[5]); p0.w = pk2(av[6], av[7]);
                p1.x = pk2(av[8], av[9]); p1.y = pk2(av[10], av[11]); p1.z = pk2(av[12], av[13]); p1.w = pk2(av[14], av[15]);
                const bf16x8 pf0 = __builtin_bit_cast(bf16x8, p0), pf1 = __builtin_bit_cast(bf16x8, p1);
                {
                    const int blk = (lane >> 4) & 1, q = (lane & 15) >> 2, p = lane & 3;
                    const unsigned vt0 = (unsigned)(size_t)vt + 8192u * kb + 256u * (4 * hh + q) + 8u * (p & 1);
                    unsigned vb[4][2];
#pragma unroll
                    for (int dt = 0; dt < 4; ++dt)
#pragma unroll
                        for (int tp = 0; tp < 2; ++tp) vb[dt][tp] = vt0 + 2048u * tp + 64u * (dt ^ q) + 16u * ((2 * blk + (p >> 1)) ^ (2 * tp + hh));
                    s16x4 vr[4][4];
                    asm volatile(
                        "ds_read_b64_tr_b16 %0, %16\n\tds_read_b64_tr_b16 %1, %17\n\tds_read_b64_tr_b16 %2, %16 offset:4096\n\tds_read_b64_tr_b16 %3, %17 offset:4096\n\t"
                        "ds_read_b64_tr_b16 %4, %18\n\tds_read_b64_tr_b16 %5, %19\n\tds_read_b64_tr_b16 %6, %18 offset:4096\n\tds_read_b64_tr_b16 %7, %19 offset:4096\n\t"
                        "ds_read_b64_tr_b16 %8, %20\n\tds_read_b64_tr_b16 %9, %21\n\tds_read_b64_tr_b16 %10, %20 offset:4096\n\tds_read_b64_tr_b16 %11, %21 offset:4096\n\t"
                        "ds_read_b64_tr_b16 %12, %22\n\tds_read_b64_tr_b16 %13, %23\n\tds_read_b64_tr_b16 %14, %22 offset:4096\n\tds_read_b64_tr_b16 %15, %23 offset:4096\n\t"
                        "s_waitcnt lgkmcnt(0)"
                        : "=&v"(vr[0][0]), "=&v"(vr[0][1]), "=&v"(vr[0][2]), "=&v"(vr[0][3]), "=&v"(vr[1][0]), "=&v"(vr[1][1]), "=&v"(vr[1][2]), "=&v"(vr[1][3]),
                          "=&v"(vr[2][0]), "=&v"(vr[2][1]), "=&v"(vr[2][2]), "=&v"(vr[2][3]), "=&v"(vr[3][0]), "=&v"(vr[3][1]), "=&v"(vr[3][2]), "=&v"(vr[3][3])
                        : "v"(vb[0][0]), "v"(vb[0][1]), "v"(vb[1][0]), "v"(vb[1][1]), "v"(vb[2][0]), "v"(vb[2][1]), "v"(vb[3][0]), "v"(vb[3][1])
                        : "memory");
#pragma unroll
                    for (int dt = 0; dt < 4; ++dt) {
                        const bf16x8 va0 = __builtin_shufflevector(vr[dt][0], vr[dt][1], 0, 1, 2, 3, 4, 5, 6, 7), va1 = __builtin_shufflevector(vr[dt][2], vr[dt][3], 0, 1, 2, 3, 4, 5, 6, 7);
                        o[dt] = __builtin_amdgcn_mfma_f32_32x32x16_bf16(va0, pf0, o[dt], 0, 0, 0);
                        o[dt] = __builtin_amdgcn_mfma_f32_32x32x16_bf16(va1, pf1, o[dt], 0, 0, 0);
                    }
                }
            }
            done = done || (R < AT_DONE);
            wdone = __all(done);
        }
        if (lane == 0) flags[(ti & 1) * 8 + w] = (wdone || !wave_active) ? 1u : 0u;
#ifdef PROBE_AT
        if (PROBE_AT == 3) at_probe_acc += __builtin_amdgcn_s_memrealtime() - ta1;
#endif
    }
}
constexpr int CW_ATQ = 8192;
struct AtU { bool valid, sample; int b, h, qt; };
DI AtU at_decode(int u) {
    AtU U; U.valid = u < 2048 + 128; U.sample = u < 128;
    if (!U.sample) { u -= 128; const int c = u & 255, rnd = u >> 8; U.qt = (rnd & 1) == 0 ? (c & 15) : 15 - (c & 15); const int bh = (c >> 4) + 16 * rnd; U.b = bh >> 4; U.h = bh & 15; }
    else { const int bh = u; U.qt = 0; U.b = (bh >> 4) & 7; U.h = bh & 15; }
    return U;
}
DI void phase_attn(const Frame& F, CParams& P, const bf16* Qb, const bf16* Kb, const bf16* Vb, const bf16* ZG, bf16* OG) {
    const float* cK = P.in[2]; const float* cV = P.in[3];
    unsigned long long at_probe_acc = 0ull;
    unsigned* qhead = (unsigned*)(P.ws + WS_CTL) + CW_ATQ;
    volatile LAS unsigned* nextu = (volatile LAS unsigned*)(F.lds + AT_FLAG + 64);
    if (F.tid == 0) nextu[0] = __hip_atomic_fetch_add(qhead, 1u, __ATOMIC_RELAXED, __HIP_MEMORY_SCOPE_AGENT);
    LDS_BARRIER();
    AtU U = at_decode((int)nextu[0]);
    LDS_BARRIER();
    if (!U.valid) return;
    bf16x8 qf[8]; f32x16 o[4];
#pragma unroll
    for (int dt = 0; dt < 4; ++dt)
#pragma unroll
        for (int i = 0; i < 16; ++i) o[dt][i] = 0.f;
    attn_prologue(F, U.sample, U.b, U.h, U.qt, qf, Qb, Kb, Vb, cK, cV);
    bool stores_behind = false;
    for (;;) {
        if (F.tid == 0) nextu[0] = __hip_atomic_fetch_add(qhead, 1u, __ATOMIC_RELAXED, __HIP_MEMORY_SCOPE_AGENT);
        attn_unit(F, U.sample, U.b, U.h, U.qt, qf, o, stores_behind, Kb, Vb, cK, cV, P.out, at_probe_acc);
        LDS_BARRIER();
        const AtU UN = at_decode((int)nextu[0]);
        if (UN.valid) attn_prologue(F, UN.sample, UN.b, UN.h, UN.qt, qf, Qb, Kb, Vb, cK, cV);
        attn_epilogue(F, U.sample, U.b, U.h, U.qt, o, ZG, OG);
        stores_behind = U.sample ? (F.wave == 0) : true;
        LDS_BARRIER();
        if (!UN.valid) break;
        U = UN;
    }
}

constexpr int G1_P = 544;
constexpr int G1_QI = 0, G1_KD = 64 * G1_P, G1_ALR = 2 * 64 * G1_P, G1_TOT = G1_ALR + 4096, G1_AM = G1_TOT + 2048;
struct G1Regs { u32x4 q[4], k[4]; f32x4 a; float wa2[16]; float ba; };
struct G1Unit { bool sample; int b, c, h; size_t row0, uh; int nvalid; };
DI G1Unit g1_decode(int u) {
    G1Unit U;
    if (u < 2048) { U.sample = false; U.b = u >> 8; U.c = (u >> 2) & 63; U.h = u & 3; U.row0 = (size_t)U.b * SEQ + U.c * 64; U.nvalid = 64; U.uh = (size_t)(U.b * 4 + U.h) * 64 + U.c; }
    else { U.sample = true; U.b = (u - 2048) >> 2; U.c = 0; U.h = (u - 2048) & 3; U.row0 = (size_t)MP + U.b * DSEQ; U.nvalid = DSEQ; U.uh = 2048 + U.b * 4 + U.h; }
    return U;
}
DI void g1_fetch(G1Regs& r, const G1Unit& U, int tid, const bf16* QK, const float* ALR, const float* wa2p, const float* bap) {
#pragma unroll
    for (int i = 0; i < 4; ++i) { const int cidx = tid + 512 * i, t = cidx >> 5, ch = cidx & 31;
        r.q[i] = (u32x4){0u, 0u, 0u, 0u}; r.k[i] = (u32x4){0u, 0u, 0u, 0u};
        if (t < U.nvalid) { r.q[i] = *(const u32x4*)(QK + (U.row0 + t) * D + U.h * 256 + ch * 8); r.k[i] = *(const u32x4*)(QK + (U.row0 + t) * D + 1024 + U.h * 256 + ch * 8); } }
    { const int t = (tid & 255) >> 2; r.a = (f32x4){0.f, 0.f, 0.f, 0.f}; if (t < U.nvalid) r.a = *(const f32x4*)(ALR + (U.row0 + t) * 16 + (tid & 3) * 4); }
    const int col = U.h * 256 + (tid & 255);
#pragma unroll
    for (int rr = 0; rr < 16; ++rr) r.wa2[rr] = wa2p[rr * 1024 + col];
    r.ba = bap[col];
}
DI void gla_prep_unit(const Frame& F, CParams& P, const G1Unit& U, G1Regs& R, bool has_next, const G1Unit& UN, bf16* QK) {
    LAS unsigned char* lds = F.lds;
    unsigned char* ws = P.ws;
    int tid = F.tid; asm volatile("" : "+v"(tid));
    const int lane = tid & 63, w = F.wave, i16 = lane & 15, g4 = lane >> 4;
    const size_t row0 = U.row0, uh = U.uh; const int nvalid = U.nvalid, h = U.h;
    bf16* KLT = (bf16*)(ws + WS_KLT); bf16* AM = (bf16*)(ws + WS_AM); float* EB = (float*)(ws + WS_EB);
    const float* ALR = (const float*)(ws + WS_ALR);
#pragma unroll
    for (int i = 0; i < 4; ++i) { const int cidx = tid + 512 * i, t = cidx >> 5, ch = cidx & 31;
        *(LAS u32x4*)(lds + G1_QI + t * G1_P + ch * 16) = R.q[i]; *(LAS u32x4*)(lds + G1_KD + t * G1_P + ch * 16) = R.k[i]; }
    *(LAS f32x4*)(lds + G1_ALR + (tid & 255) * 16) = R.a;
    const int dk = tid & 255, half = tid >> 8;
    float wa2[16];
#pragma unroll
    for (int rr = 0; rr < 16; ++rr) wa2[rr] = R.wa2[rr] * 1.4426950408889634f;
    const float ba = R.ba * 1.4426950408889634f;
    LDS_BARRIER();
    if (has_next) g1_fetch(R, UN, tid, QK, ALR, P.in[13], P.in[14]);
    const LAS float* alr = (const LAS float*)(lds + G1_ALR);
    LAS float* tot = (LAS float*)(lds + G1_TOT);
    float gl[32]; float pre = 0.f;
#pragma unroll
    for (int tt = 0; tt < 32; ++tt) {
        const int t = 32 * half + tt;
        float x = ba;
#pragma unroll
        for (int j = 0; j < 4; ++j) { const f32x4 av = *(const LAS f32x4*)(alr + t * 16 + 4 * j); x += av[0] * wa2[4 * j] + av[1] * wa2[4 * j + 1] + av[2] * wa2[4 * j + 2] + av[3] * wa2[4 * j + 3]; }
        const float lsig2 = __builtin_fminf(x, 0.f) - __builtin_amdgcn_logf(1.0f + __builtin_amdgcn_exp2f(-__builtin_fabsf(x)));
        const float gt = (t < nvalid) ? lsig2 * 0.0625f : 0.f;
        pre += gt; gl[tt] = pre;
    }
    tot[half * 256 + dk] = pre;
    LDS_BARRIER();
    const float t0 = tot[dk], t1 = tot[256 + dk];
    const float boff = half ? t0 : 0.f, blast = t0 + t1;
    unsigned klw[16];
#pragma unroll
    for (int tt = 0; tt < 32; tt += 2) {
        float klv[2];
#pragma unroll
        for (int q2 = 0; q2 < 2; ++q2) {
            const int t = 32 * half + tt + q2;
            const float bt = boff + gl[tt + q2];
            LAS unsigned short* qp = (LAS unsigned short*)(lds + G1_QI + t * G1_P + dk * 2);
            LAS unsigned short* kp = (LAS unsigned short*)(lds + G1_KD + t * G1_P + dk * 2);
            const float qv = bf2f(*qp), kv = bf2f(*kp);
            const float qi = qv * 0.0625f * __builtin_amdgcn_exp2f(bt), kd = kv * __builtin_amdgcn_exp2f(-bt);
            klv[q2] = kv * __builtin_amdgcn_exp2f(blast - bt);
            *qp = (unsigned short)(pk2(qi, 0.f) & 0xffffu);
            *kp = (unsigned short)(pk2(kd, 0.f) & 0xffffu);
        }
        klw[tt >> 1] = pk2(klv[0], klv[1]);
    }
    {
        u32x4* dst = (u32x4*)(KLT + (uh * 256 + dk) * 64 + 32 * half);
#pragma unroll
        for (int j = 0; j < 4; ++j) dst[j] = (u32x4){klw[4 * j], klw[4 * j + 1], klw[4 * j + 2], klw[4 * j + 3]};
    }
    if (half == 1) EB[uh * 256 + dk] = __builtin_amdgcn_exp2f(blast);
    LDS_BARRIER();
    {
        const int ct = w >> 1;
#pragma unroll
        for (int sti = 0; sti < 2; ++sti) {
            const int st = 2 * (w & 1) + sti;
            f32x4 accA = {0.f, 0.f, 0.f, 0.f};
#pragma unroll
            for (int ks = 0; ks < 8; ++ks) {
                const bf16x8 a = *(const LAS bf16x8*)(lds + G1_QI + (16 * ct + i16) * G1_P + (32 * ks + 8 * g4) * 2);
                const bf16x8 bb = *(const LAS bf16x8*)(lds + G1_KD + (16 * st + i16) * G1_P + (32 * ks + 8 * g4) * 2);
                accA = __builtin_amdgcn_mfma_f32_16x16x32_bf16(a, bb, accA, 0, 0, 0);
            }
#pragma unroll
            for (int e = 0; e < 4; ++e) { const int cc = 16 * ct + 4 * g4 + e, ss = 16 * st + i16; const float v = cc >= ss ? accA[e] : 0.f;
                *(LAS unsigned short*)(lds + G1_AM + cc * 128 + ss * 2) = (unsigned short)(pk2(v, 0.f) & 0xffffu); }
        }
    }
#pragma unroll
    for (int i = 0; i < 4; ++i) { const int cidx = tid + 512 * i, t = cidx >> 5, ch = cidx & 31;
        if (t < nvalid) *(u32x4*)(QK + (row0 + t) * D + h * 256 + ch * 8) = *(const LAS u32x4*)(lds + G1_QI + t * G1_P + ch * 16); }
    LDS_BARRIER();
    *(u32x4*)(AM + uh * 4096 + tid * 8) = *(const LAS u32x4*)(lds + G1_AM + tid * 16);
}
DI void phase_gla_prep(const Frame& F, CParams& P, bf16* QK) {
    int u = (int)blockIdx.x;
    if (u >= 2080) return;
    G1Regs R; G1Unit U = g1_decode(u);
    g1_fetch(R, U, F.tid, QK, (const float*)(P.ws + WS_ALR), P.in[13], P.in[14]);
    for (;;) {
        const int un = u + F.G; const bool has_next = un < 2080;
        const G1Unit UN = g1_decode(has_next ? un : u);
        gla_prep_unit(F, P, U, R, has_next, UN, QK);
        if (!has_next) break;
        u = un; U = UN;
    }
}

constexpr int G2_QP = 544, G2_TP = 160;
constexpr int G2_QI = 0, G2_VT = 64 * G2_QP, G2_AM = G2_VT + 64 * G2_TP, G2_EB = G2_AM + 64 * G2_TP;
struct G2Regs { u32x4 q[4], v, a; };
DI void g2_fetch(G2Regs& r, int tid, int nvalid, const bf16* qb, const bf16* vbp, const bf16* ab) {
#pragma unroll
    for (int i = 0; i < 4; ++i) {
        const unsigned cidx = tid + 512 * i;
        { const unsigned t = cidx >> 5, ch = cidx & 31; r.q[i] = (u32x4){0u, 0u, 0u, 0u}; if ((int)t < nvalid) r.q[i] = *(const u32x4*)(qb + (t * (unsigned)D + ch * 8u)); }
    }
    { const unsigned t = tid & 63, dch = tid >> 6; r.v = (u32x4){0u, 0u, 0u, 0u}; if ((int)t < nvalid) r.v = *(const u32x4*)(vbp + (t * (unsigned)D + dch * 8u)); }
    r.a = *(const u32x4*)(ab + (unsigned)tid * 8u);
}
DI void g2_fetch_kl(bf16x8 (&kl)[4][2], f32x4 (&eb)[4], const bf16* klt, const float* ebp, int w, int i16, int g4) {
#pragma unroll
    for (int jt = 0; jt < 4; ++jt) {
        const bf16* p = klt + (unsigned)((64 * w + 16 * jt + i16) * 64 + 8 * g4);
        kl[jt][0] = *(const bf16x8*)p; kl[jt][1] = *(const bf16x8*)(p + 32);
        eb[jt] = *(const f32x4*)(ebp + 64 * w + 16 * jt + 4 * g4);
    }
}
DI void g2_stage(const G2Regs& r, LAS unsigned char* lds, int tid) {
#pragma unroll
    for (int i = 0; i < 4; ++i) {
        const int cidx = tid + 512 * i;
        { const int t = cidx >> 5, ch = cidx & 31; *(LAS u32x4*)(lds + G2_QI + t * G2_QP + ch * 16) = r.q[i]; }
    }
    { const int t = tid & 63, dch = tid >> 6; const u32x4 v = r.v;
      LAS unsigned short* vt = (LAS unsigned short*)(lds + G2_VT + (dch * 8) * G2_TP + t * 2);
      vt[0 * (G2_TP / 2)] = (unsigned short)(v.x & 0xffffu); vt[1 * (G2_TP / 2)] = (unsigned short)(v.x >> 16);
      vt[2 * (G2_TP / 2)] = (unsigned short)(v.y & 0xffffu); vt[3 * (G2_TP / 2)] = (unsigned short)(v.y >> 16);
      vt[4 * (G2_TP / 2)] = (unsigned short)(v.z & 0xffffu); vt[5 * (G2_TP / 2)] = (unsigned short)(v.z >> 16);
      vt[6 * (G2_TP / 2)] = (unsigned short)(v.w & 0xffffu); vt[7 * (G2_TP / 2)] = (unsigned short)(v.w >> 16); }
    { const int cc = tid >> 3, ch = tid & 7; *(LAS u32x4*)(lds + G2_AM + cc * G2_TP + ch * 16) = r.a; }
}
constexpr int G2_SP = G2_EB + 1024, G2_SPP = 528, G2_SPB = 16 * G2_SPP;
static_assert(G2_SP + 8 * G2_SPB <= LDS_MISC, "G2 LDS map");
DI void g2_flush_o(LAS unsigned char* lds, int buf, int tid, int nvalid, bf16* obase, float* sbq) {
    const int cc = tid >> 3, dq = (tid >> 1) & 3, half = tid & 1;
    const u32x4 v = *(const LAS u32x4*)(lds + G2_SP + (buf * 4 + dq) * G2_SPB + cc * 32 + half * 16);
    float ss = (bflo(v.x) * bflo(v.x) + bfhi(v.x) * bfhi(v.x)) + (bflo(v.y) * bflo(v.y) + bfhi(v.y) * bfhi(v.y)) + (bflo(v.z) * bflo(v.z) + bfhi(v.z) * bfhi(v.z)) + (bflo(v.w) * bflo(v.w) + bfhi(v.w) * bfhi(v.w));
    ss += dppf<0xB1>(ss); ss += dppf<0x4E>(ss); ss += dppf<0x141>(ss);
    if (cc < nvalid) {
        *(u32x4*)(obase + (unsigned)(cc * D + 16 * dq + 8 * half)) = v;
        if ((tid & 7) == 0) sbq[(unsigned)(cc * 32)] = ss;
    }
}
DI void gla_scan_unit(const Frame& F, CParams& P, bool sample, int b, int h, int sl, const bf16* QK, const bf16* V1, bf16* Ob, unsigned long long& g2_probe_acc) {
    (void)g2_probe_acc;
    LAS unsigned char* lds = F.lds;
    unsigned char* ws = P.ws;
    const int w = F.wave, swave = w < 4, dq = w & 3;
    const bf16* KLT = (const bf16*)(ws + WS_KLT); const bf16* AM = (const bf16*)(ws + WS_AM); const float* EB = (const float*)(ws + WS_EB);
    float* SSQ = (float*)(ws + WS_SSQ);
    f32x4 S[16];
    const int lane0 = F.lane, i16_0 = lane0 & 15, g4_0 = lane0 >> 4;
    const size_t sbase = ((size_t)(b * 4 + h) * 256 + 64 * (w & 3) + 4 * g4_0) * 512 + sl * 64 + i16_0;
#pragma unroll
    for (int j = 0; j < 16; ++j) S[j] = (f32x4){0.f, 0.f, 0.f, 0.f};
    if (sample && swave) {
        const float* st = P.in[4] + sbase;
#pragma unroll
        for (int j = 0; j < 16; ++j) {
            const float* pj = st + (size_t)(16 * (j >> 2)) * 512 + 16 * (j & 3); asm volatile("" : "+v"(pj));
#pragma unroll
            for (int e = 0; e < 4; ++e) S[j][e] = pj[e * 512];
        }
    }
    if (swave) {
        LAS unsigned char* sp = lds + G2_SP + 4 * G2_SPB + i16_0 * G2_SPP + (64 * w + 4 * g4_0) * 2;
#pragma unroll
        for (int j = 0; j < 16; ++j) *(LAS u32x2*)(sp + (j & 3) * G2_SPB + 32 * (j >> 2)) = (u32x2){pk2(S[j][0], S[j][1]), pk2(S[j][2], S[j][3])};
    }
    const int nchunks = sample ? 1 : 64, nvalid = sample ? DSEQ : 64;
    const size_t rowb = sample ? (size_t)MP + b * DSEQ : (size_t)b * SEQ;
    const size_t uhb = sample ? 2048 + b * 4 + h : (size_t)(b * 4 + h) * 64;
    G2Regs R;
    { int t0 = F.tid; asm volatile("" : "+v"(t0)); g2_fetch(R, t0, nvalid, QK + rowb * D + h * 256, V1 + rowb * D + h * 512 + sl * 64, AM + uhb * 4096); }
    bf16x8 klN[4][2]; f32x4 ebN[4];
    if (swave) { int ln0 = F.lane; asm volatile("" : "+v"(ln0)); g2_fetch_kl(klN, ebN, KLT + uhb * 16384, EB + uhb * 256, w, ln0 & 15, ln0 >> 4); }
    for (int c = 0; c < nchunks; ++c) {
        const size_t row0 = rowb + (size_t)c * 64;
        int tid = F.tid; asm volatile("" : "+v"(tid));
        const int lane = tid & 63, i16 = lane & 15, g4 = lane >> 4;
        g2_stage(R, lds, tid);
        if (c > 0) g2_flush_o(lds, c & 1, tid, nvalid, Ob + (row0 - 64) * D + h * 512 + sl * 64, SSQ + (row0 - 64) * 32 + h * 8 + sl);
        LDS_BARRIER();
        if (c + 1 < nchunks) g2_fetch(R, tid, nvalid, QK + (row0 + 64) * D + h * 256, V1 + (row0 + 64) * D + h * 512 + sl * 64, AM + (uhb + c + 1) * 4096);
        if (swave) {
            __builtin_amdgcn_s_setprio(2);
            bf16x8 vall[4][2];
#pragma unroll
            for (int q = 0; q < 4; ++q)
#pragma unroll
                for (int ks = 0; ks < 2; ++ks) vall[q][ks] = *(const LAS bf16x8*)(lds + G2_VT + (16 * q + i16) * G2_TP + (32 * ks + 8 * g4) * 2);
            LAS unsigned char* sp = lds + G2_SP + ((c & 1) * 4) * G2_SPB + i16 * G2_SPP + (64 * w + 4 * g4) * 2;
#pragma unroll
            for (int jt = 0; jt < 4; ++jt)
#pragma unroll
                for (int q = 0; q < 4; ++q) { const int j = 4 * jt + q; S[j] = S[j] * ebN[jt];
                    S[j] = __builtin_amdgcn_mfma_f32_16x16x32_bf16(klN[jt][0], vall[q][0], S[j], 0, 0, 0); S[j] = __builtin_amdgcn_mfma_f32_16x16x32_bf16(klN[jt][1], vall[q][1], S[j], 0, 0, 0); }
            if (c + 1 < nchunks) g2_fetch_kl(klN, ebN, KLT + (uhb + c + 1) * 16384, EB + (uhb + c + 1) * 256, w, i16, g4);
#pragma unroll
            for (int j = 0; j < 16; ++j) *(LAS u32x2*)(sp + (j & 3) * G2_SPB + 32 * (j >> 2)) = (u32x2){pk2(S[j][0], S[j][1]), pk2(S[j][2], S[j][3])};
            __builtin_amdgcn_s_setprio(0);
        } else {
            bf16x8 vb[2];
#pragma unroll
            for (int ks = 0; ks < 2; ++ks) vb[ks] = *(const LAS bf16x8*)(lds + G2_VT + (16 * dq + i16) * G2_TP + (32 * ks + 8 * g4) * 2);
            LAS unsigned char* slice = lds + G2_SP + (((c + 1) & 1) * 4 + dq) * G2_SPB;
            bf16x8 bS[8];
#pragma unroll
            for (int ks = 0; ks < 8; ++ks) bS[ks] = *(const LAS bf16x8*)(slice + i16 * G2_SPP + (8 * g4) * 2 + 64 * ks);
            const LAS unsigned char* amp = lds + G2_AM + i16 * G2_TP + (8 * g4) * 2;
            const LAS unsigned char* qip = lds + G2_QI + i16 * G2_QP + (8 * g4) * 2;
            f32x4 O[4];
            bf16x8 amA[2], qaA[8], amB[2], qaB[8];
#define G2_LDF(am_, qa_, ct_) do { am_[0] = *(const LAS bf16x8*)(amp + (16 * (ct_)) * G2_TP); am_[1] = *(const LAS bf16x8*)(amp + (16 * (ct_)) * G2_TP + 64); \
            _Pragma("unroll") for (int ks = 0; ks < 8; ++ks) qa_[ks] = *(const LAS bf16x8*)(qip + (16 * (ct_)) * G2_QP + 64 * ks); } while (0)
#define G2_MMO(am_, qa_, ct_) do { f32x4 oa_ = __builtin_amdgcn_mfma_f32_16x16x32_bf16(am_[0], vb[0], (f32x4){0.f, 0.f, 0.f, 0.f}, 0, 0, 0), ob_ = __builtin_amdgcn_mfma_f32_16x16x32_bf16(am_[1], vb[1], (f32x4){0.f, 0.f, 0.f, 0.f}, 0, 0, 0); \
            _Pragma("unroll") for (int ks = 0; ks < 8; ks += 2) { oa_ = __builtin_amdgcn_mfma_f32_16x16x32_bf16(qa_[ks], bS[ks], oa_, 0, 0, 0); ob_ = __builtin_amdgcn_mfma_f32_16x16x32_bf16(qa_[ks + 1], bS[ks + 1], ob_, 0, 0, 0); } \
            O[ct_] = oa_ + ob_; } while (0)
            G2_LDF(amA, qaA, 0);
            __builtin_amdgcn_sched_barrier(0);
            G2_LDF(amB, qaB, 1); G2_MMO(amA, qaA, 0);
            __builtin_amdgcn_sched_barrier(0);
            G2_LDF(amA, qaA, 2); G2_MMO(amB, qaB, 1);
            __builtin_amdgcn_sched_barrier(0);
            G2_LDF(amB, qaB, 3); G2_MMO(amA, qaA, 2);
            __builtin_amdgcn_sched_barrier(0);
            G2_MMO(amB, qaB, 3);
#undef G2_LDF
#undef G2_MMO
#pragma unroll
            for (int ct = 0; ct < 4; ++ct)
#pragma unroll
                for (int e = 0; e < 4; ++e) *(LAS unsigned short*)(slice + (16 * ct + 4 * g4 + e) * 32 + i16 * 2) = (unsigned short)(pk2(O[ct][e], 0.f) & 0xffffu);
        }
        LDS_BARRIER();
    }
    {
        int tid = F.tid; asm volatile("" : "+v"(tid));
        const size_t rowl = rowb + (size_t)(nchunks - 1) * 64;
        g2_flush_o(lds, nchunks & 1, tid, nvalid, Ob + rowl * D + h * 512 + sl * 64, SSQ + rowl * 32 + h * 8 + sl);
    }
    if (swave) {
        float* so = P.out + (sample ? OSS : OSP) + sbase;
#pragma unroll
        for (int j = 0; j < 16; ++j) {
            float* pj = so + (size_t)(16 * (j >> 2)) * 512 + 16 * (j & 3); asm volatile("" : "+v"(pj));
#pragma unroll
            for (int e = 0; e < 4; ++e) pj[e * 512] = S[j][e];
        }
    }
    LDS_BARRIER();
}
DI void phase_gla_scan(const Frame& F, CParams& P, const bf16* QK, const bf16* V1, bf16* Ob) {
    unsigned long long g2_probe_acc = 0ull;
    for (int u = blockIdx.x; u < 512; u += F.G) {
        const int v = u & 255, x = v & 7, j = v >> 3, p = x + 8 * (j >> 3), sl = j & 7;
        gla_scan_unit(F, P, u >= 256, p >> 2, p & 3, sl, QK, V1, Ob, g2_probe_acc);
    }
#ifdef PROBE_G2
    if (blockIdx.x == 0 && F.tid == (PROBE_G2 == 4 ? 256 : 0)) { const unsigned long long t0_ = __builtin_amdgcn_s_memrealtime(); while (__builtin_amdgcn_s_memrealtime() - t0_ < g2_probe_acc) __builtin_amdgcn_s_sleep(8); }
#endif
}

DI void phase_gla_gate(const Frame& F, CParams& P, bf16* Ob, const bf16* Rb) {
    const int gw = F.vcu * 8 + F.wave, NGW = F.G * 8, lane = F.lane;
    const float* SSQ = (const float*)(P.ws + WS_SSQ); const float* gn = P.in[15];
    for (int m = gw; m < MV; m += NGW) {
        float sq = lane < 32 ? SSQ[(size_t)m * 32 + lane] : 0.f;
        sq += __shfl_xor(sq, 1); sq += __shfl_xor(sq, 2); sq += __shfl_xor(sq, 4);
        const float rsv = 1.0f / sqrtf(sq * (1.0f / GDV) + EPS);
#pragma unroll
        for (int j = 0; j < 4; ++j) {
            const float rs = __shfl(rsv, 8 * j);
            const int col = 8 * lane + 512 * j;
            const u32x4 ov = *(const u32x4*)(Ob + (size_t)m * D + col), rv = *(const u32x4*)(Rb + (size_t)m * D + col);
            const f32x4 g0 = *(const f32x4*)(gn + col), g1 = *(const f32x4*)(gn + col + 4);
            u32x4 y;
            y.x = pk2(bflo(ov.x) * rs * g0[0] * bflo(rv.x), bfhi(ov.x) * rs * g0[1] * bfhi(rv.x));
            y.y = pk2(bflo(ov.y) * rs * g0[2] * bflo(rv.y), bfhi(ov.y) * rs * g0[3] * bfhi(rv.y));
            y.z = pk2(bflo(ov.z) * rs * g1[0] * bflo(rv.z), bfhi(ov.z) * rs * g1[1] * bfhi(rv.z));
            y.w = pk2(bflo(ov.w) * rs * g1[2] * bflo(rv.w), bfhi(ov.w) * rs * g1[3] * bfhi(rv.w));
            *(u32x4*)(Ob + (size_t)m * D + col) = y;
        }
    }
}

DI void phase_final_norm(const Frame& F, CParams& P, const bf16* X2) {
    const int gw = F.vcu * 8 + F.wave, NGW = F.G * 8, lane = F.lane;
    const float* fg = P.in[17]; const float* SS2 = (const float*)(P.ws + WS_SS2);
    for (int m = gw; m < MV; m += NGW) {
        float ss = lane < 32 ? SS2[(size_t)m * 32 + lane] : 0.f;
        ss = wave_sum(ss);
        const float rstd = 1.0f / sqrtf(ss * (1.0f / D) + EPS);
        const u32x4* xr = (const u32x4*)(X2 + (size_t)m * D) + lane;
        float* yo = P.out + OY + (size_t)m * D + 8 * lane;
#pragma unroll
        for (int j = 0; j < 4; ++j) {
            const u32x4 xv = xr[64 * j];
            const f32x4 g0 = *(const f32x4*)(fg + 8 * lane + 512 * j), g1 = *(const f32x4*)(fg + 8 * lane + 512 * j + 4);
            const f32x4 y0 = (f32x4){bflo(xv.x), bfhi(xv.x), bflo(xv.y), bfhi(xv.y)} * rstd * g0, y1 = (f32x4){bflo(xv.z), bfhi(xv.z), bflo(xv.w), bfhi(xv.w)} * rstd * g1;
            __builtin_nontemporal_store(y0, (f32x4*)(yo + 512 * j)); __builtin_nontemporal_store(y1, (f32x4*)(yo + 512 * j + 4));
        }
    }
}

DI void phase_norm_mod_alr_generic(const Frame& F, CParams& P, const bf16* X1, bf16* H) {
    const int gw = F.vcu * 8 + F.wave, NGW = F.G * 8, lane = F.lane, i16 = lane & 15, g4 = lane >> 4;
    const float* ADA = (const float*)(P.ws + WS_ADA) + (size_t)16 * 6144;
    const float* ng = P.in[9] + D;
    const float* SS2 = (const float*)(P.ws + WS_SS2);
    const bf16* WA = (const bf16*)(P.ws + WS_WA);
    float* ALR = (float*)(P.ws + WS_ALR);
    for (int tk = gw; tk < MT / 16; tk += NGW) {
        const size_t m = (size_t)16 * tk + i16;
        if (16 * tk >= MV) {
            u32x4* o = (u32x4*)(H + m * D) + g4;
#pragma unroll 8
            for (int ks = 0; ks < 64; ++ks) o[4 * ks] = (u32x4){0u, 0u, 0u, 0u};
            continue;
        }
        const int ai = tk < MP / 16 ? (tk >> 8) : 8 + (tk - MP / 16);
        const float* sh = ADA + (size_t)ai * 6144, *sc = sh + 2048;
        float ss = 0.f;
        { const f32x4 a = *(const f32x4*)(SS2 + m * 32 + 8 * g4), b2 = *(const f32x4*)(SS2 + m * 32 + 8 * g4 + 4); ss = (a[0] + a[1]) + (a[2] + a[3]) + (b2[0] + b2[1]) + (b2[2] + b2[3]); }
        ss += __shfl_xor(ss, 16); ss += __shfl_xor(ss, 32);
        const float rstd = 1.0f / sqrtf(ss * (1.0f / D) + EPS);
        const bf16* xrow = X1 + m * D;
        f32x4 acc = {0.f, 0.f, 0.f, 0.f};
#pragma unroll 4
        for (int ks = 0; ks < 64; ++ks) {
            const int k0 = 32 * ks + 8 * g4;
            const u32x4 xv = *(const u32x4*)(xrow + k0);
            const f32x4 x0 = {bflo(xv.x), bfhi(xv.x), bflo(xv.y), bfhi(xv.y)}, x1 = {bflo(xv.z), bfhi(xv.z), bflo(xv.w), bfhi(xv.w)};
            const f32x4 gA = *(const f32x4*)(ng + k0), gB = *(const f32x4*)(ng + k0 + 4);
            const f32x4 cA = *(const f32x4*)(sc + k0), cB = *(const f32x4*)(sc + k0 + 4);
            const f32x4 hA = *(const f32x4*)(sh + k0), hB = *(const f32x4*)(sh + k0 + 4);
            const bf16x8 bfr = *(const bf16x8*)(WA + i16 * D + k0);
            const f32x4 y0 = (x0 * rstd) * gA * (cA + 1.0f) + hA, y1 = (x1 * rstd) * gB * (cB + 1.0f) + hB;
            u32x4 w; w.x = pk2(y0[0], y0[1]); w.y = pk2(y0[2], y0[3]); w.z = pk2(y1[0], y1[1]); w.w = pk2(y1[2], y1[3]);
            *(u32x4*)(H + m * D + k0) = w;
            acc = __builtin_amdgcn_mfma_f32_16x16x32_bf16(__builtin_bit_cast(bf16x8, w), bfr, acc, 0, 0, 0);
        }
#pragma unroll
        for (int e = 0; e < 4; ++e) ALR[((size_t)16 * tk + 4 * g4 + e) * 16 + i16] = acc[e];
    }
}

constexpr int P5_WAP = 4112;
constexpr int P5_WA = 0, P5_GM = 16 * P5_WAP, P5_SH = P5_GM + 8192, P5_RED = P5_SH + 8192;
DI void p5_tables(const Frame& F, CParams& P, int ai) {
    const float* ADA = (const float*)(P.ws + WS_ADA) + (size_t)16 * 6144 + (size_t)ai * 6144;
    const float* ng = P.in[9] + D;
    { const int c = 4 * F.tid;
      const f32x4 g = *(const f32x4*)(ng + c), sc = *(const f32x4*)(ADA + 2048 + c), sh = *(const f32x4*)(ADA + c);
      *(LAS f32x4*)(F.lds + P5_GM + c * 4) = g * (sc + 1.0f); *(LAS f32x4*)(F.lds + P5_SH + c * 4) = sh; }
}
DI f32x4 p5_rows(const Frame& F, const bf16* X1, bf16* H, size_t m, float rstd, int ks_lo, int ks_hi, int i16, int g4) {
    const bf16* xrow = X1 + m * D;
    f32x4 accq[4];
#pragma unroll
    for (int q = 0; q < 4; ++q) accq[q] = (f32x4){0.f, 0.f, 0.f, 0.f};
    for (int ks0 = ks_lo; ks0 < ks_hi; ks0 += 8) {
        u32x4 xv[8];
#pragma unroll
        for (int q = 0; q < 8; ++q) xv[q] = *(const u32x4*)(xrow + 32 * (ks0 + q) + 8 * g4);
#pragma unroll
        for (int q = 0; q < 8; ++q) {
            const int k0 = 32 * (ks0 + q) + 8 * g4;
            const f32x4 x0 = {bflo(xv[q].x), bfhi(xv[q].x), bflo(xv[q].y), bfhi(xv[q].y)}, x1 = {bflo(xv[q].z), bfhi(xv[q].z), bflo(xv[q].w), bfhi(xv[q].w)};
            const f32x4 gA = *(const LAS f32x4*)(F.lds + P5_GM + k0 * 4), gB = *(const LAS f32x4*)(F.lds + P5_GM + k0 * 4 + 16);
            const f32x4 hA = *(const LAS f32x4*)(F.lds + P5_SH + k0 * 4), hB = *(const LAS f32x4*)(F.lds + P5_SH + k0 * 4 + 16);
            const bf16x8 bfr = *(const LAS bf16x8*)(F.lds + P5_WA + i16 * P5_WAP + k0 * 2);
            const f32x4 y0 = (x0 * rstd) * gA + hA, y1 = (x1 * rstd) * gB + hB;
            u32x4 w; w.x = pk2(y0[0], y0[1]); w.y = pk2(y0[2], y0[3]); w.z = pk2(y1[0], y1[1]); w.w = pk2(y1[2], y1[3]);
            *(u32x4*)(H + m * D + k0) = w;
            accq[q & 3] = __builtin_amdgcn_mfma_f32_16x16x32_bf16(__builtin_bit_cast(bf16x8, w), bfr, accq[q & 3], 0, 0, 0);
        }
    }
    return (accq[0] + accq[1]) + (accq[2] + accq[3]);
}
DI float p5_rstd(const float* SS2, size_t m, int g4) {
    const f32x4 a = *(const f32x4*)(SS2 + m * 32 + 8 * g4), b2 = *(const f32x4*)(SS2 + m * 32 + 8 * g4 + 4);
    float ss = (a[0] + a[1]) + (a[2] + a[3]) + (b2[0] + b2[1]) + (b2[2] + b2[3]);
    ss += __shfl_xor(ss, 16); ss += __shfl_xor(ss, 32);
    return 1.0f / sqrtf(ss * (1.0f / D) + EPS);
}
DI void phase_norm_mod_alr(const Frame& F, CParams& P, const bf16* X1, bf16* H) {
    if (F.G != 256) { phase_norm_mod_alr_generic(F, P, X1, H); return; }
    const int lane = F.lane, i16 = lane & 15, g4 = lane >> 4, v = F.vcu, w = F.wave;
    const float* SS2 = (const float*)(P.ws + WS_SS2);
    const bf16* WA = (const bf16*)(P.ws + WS_WA);
    float* ALR = (float*)(P.ws + WS_ALR);
    for (int idx = F.tid; idx < 4096; idx += 512) { const int r = idx >> 8, ch = idx & 255; *(LAS u32x4*)(F.lds + P5_WA + r * P5_WAP + ch * 16) = *(const u32x4*)(WA + r * D + ch * 8); }
    p5_tables(F, P, v >> 5);
    __syncthreads();
    {
        const size_t m = (size_t)128 * v + 16 * w + i16;
        const f32x4 acc = p5_rows(F, X1, H, m, p5_rstd(SS2, m, g4), 0, 64, i16, g4);
#pragma unroll
        for (int e = 0; e < 4; ++e) ALR[((size_t)128 * v + 16 * w + 4 * g4 + e) * 16 + i16] = acc[e];
    }
    if (v < 8) {
        __syncthreads();
        p5_tables(F, P, 8 + v);
        __syncthreads();
        const size_t m = (size_t)MP + 16 * v + i16;
        const f32x4 acc = p5_rows(F, X1, H, m, p5_rstd(SS2, m, g4), 8 * w, 8 * w + 8, i16, g4);
        LAS float* red = (LAS float*)(F.lds + P5_RED) + w * 256;
#pragma unroll
        for (int e = 0; e < 4; ++e) red[(4 * g4 + e) * 16 + i16] = acc[e];
        __syncthreads();
        if (F.tid < 256) { float sum = 0.f;
#pragma unroll
            for (int wv = 0; wv < 8; ++wv) sum += *((const LAS float*)(F.lds + P5_RED) + wv * 256 + F.tid);
            ALR[((size_t)MP + 16 * v) * 16 + F.tid] = sum; }
    }
}

__global__ void __launch_bounds__(512, 2) fwd_kernel(Params P_arg) {
    extern __shared__ __attribute__((aligned(16))) unsigned char lds_raw[];
    (void)P_arg;
    CParams& P = *(CParams*)__builtin_amdgcn_kernarg_segment_ptr();
    Frame F;
    F.lds = (LAS unsigned char*)lds_raw;
    F.tid = threadIdx.x; F.lane = F.tid & 63; F.wave = __builtin_amdgcn_readfirstlane(F.tid >> 6);
    F.G = gridDim.x; { const int bx = blockIdx.x; F.vcu = (F.G % 8 == 0) ? (bx % 8) * (F.G / 8) + bx / 8 : bx; }
    volatile LAS unsigned* MISC = (volatile LAS unsigned*)(F.lds + LDS_MISC);
    if (F.tid < 16) MISC[F.tid] = 0u;
    __syncthreads();
    XcdBarrier bar = xcd_barrier_post((unsigned*)(P.ws + WS_CTL) + CW_BAR, MISC);
#define R0 ((bf16*)(P.ws + WS_R0))
#define R1 ((bf16*)(P.ws + WS_R0 + RSZ))
#define R2 ((bf16*)(P.ws + WS_R0 + 2 * RSZ))
#define R3 ((bf16*)(P.ws + WS_R0 + 3 * RSZ))
#define R4 ((bf16*)(P.ws + WS_R0 + 4 * RSZ))
#define R5 ((bf16*)(P.ws + WS_R0 + 5 * RSZ))

#ifdef PROBE_MASK
    unsigned long long pr_acc = 0ull, pr_last = __builtin_amdgcn_s_memrealtime();
#define GRID_BAR(id) do { xcd_barrier(bar); { const unsigned long long now_ = __builtin_amdgcn_s_memrealtime(); if ((PROBE_MASK >> (id)) & 1u) pr_acc += now_ - pr_last; pr_last = now_; } } while (0)
#else
#define GRID_BAR(id) xcd_barrier(bar)
#endif
    const bool stag = (F.G == 256);
    const int mini_xcd = (int)blockIdx.x & 7, mini_idx = ((int)blockIdx.x >> 3) * 4 + (mini_xcd & 3);
#define MINI_EARLY(A_, Bt_, N_, ME_) do { if (stag && mini_xcd < 4) mini_gemm(F, A_, Bt_, ME_, mini_idx, 128, (N_) / 16 < 256 ? (N_) / 16 : 256); } while (0)
#define MINI_LATE(A_, Bt_, N_, ME_) do { if (!stag) mini_gemm(F, A_, Bt_, ME_, (int)blockIdx.x, F.G, (N_) / 16); else if (mini_xcd >= 4) mini_gemm(F, A_, Bt_, ME_, 256 + mini_idx, 128, (N_) / 16); } while (0)
    phase0_ada(F, P);
    GRID_BAR(0);
    phase0_transposes(F, P);
    phase_norm_mod(F, P, 0, R0);
    GRID_BAR(1);
    {
        pg8::Gemm g{R0, (const bf16*)(P.ws + WS_W1T), MP, 8192, D}; pg8::StaticOrder S; S.init(MP, 8192, F.G, (int)blockIdx.x);
        Epi1 E{P.ws, 0.08838834764831845f * 1.4426950408889634f};
        Mini1 ME{P.ws, 0.08838834764831845f * 1.4426950408889634f};
        MINI_EARLY(R0 + (size_t)MP * D, (const bf16*)(P.ws + WS_W1T), 8192, ME);
        pg8::gemm_phase<Epi1, pg8::StaticOrder, true, true>(F.lds, g, S, E);
        MINI_LATE(R0 + (size_t)MP * D, (const bf16*)(P.ws + WS_W1T), 8192, ME);
    }
#if LAST_PHASE >= 3
    GRID_BAR(2);
    phase_attn(F, P, R1, R2, R3, R4, R1);
#endif
#if LAST_PHASE >= 4
    GRID_BAR(3);
    {
        pg8::Gemm g{R1, (const bf16*)(P.ws + WS_W2T), MP, 2048, D}; pg8::StaticOrder S; S.init(MP, 2048, F.G, (int)blockIdx.x);
        EpiRes<false> E{P.in[0], R3, (const float*)(P.ws + WS_ADA) + 4096, (float*)(P.ws + WS_SS2)};
        MiniRes<false> ME{P.in[1], R3 + (size_t)MP * D, (const float*)(P.ws + WS_ADA) + 4096, (float*)(P.ws + WS_SS2)};
        MINI_EARLY(R1 + (size_t)MP * D, (const bf16*)(P.ws + WS_W2T), 2048, ME);
        pg8::gemm_phase<EpiRes<false>, pg8::StaticOrder, true, true>(F.lds, g, S, E);
        MINI_LATE(R1 + (size_t)MP * D, (const bf16*)(P.ws + WS_W2T), 2048, ME);
    }
#endif
#if LAST_PHASE >= 5
    GRID_BAR(4);
    phase_norm_mod_alr(F, P, R3, R0);
    GRID_BAR(5);
    {
        pg8::Gemm g{R0, (const bf16*)(P.ws + WS_W3T), MP, 6144, D}; pg8::StaticOrder S; S.init(MP, 6144, F.G, (int)blockIdx.x);
        Epi3 E{P.ws};
        Mini3 ME{P.ws};
        MINI_EARLY(R0 + (size_t)MP * D, (const bf16*)(P.ws + WS_W3T), 6144, ME);
        pg8::gemm_phase<Epi3, pg8::StaticOrder, true, true>(F.lds, g, S, E);
        MINI_LATE(R0 + (size_t)MP * D, (const bf16*)(P.ws + WS_W3T), 6144, ME);
    }
    GRID_BAR(6);
    phase_gla_prep(F, P, R1);
    GRID_BAR(7);
    phase_gla_scan(F, P, R1, R4, R2);
#endif
#if LAST_PHASE >= 9
    GRID_BAR(8);
    phase_gla_gate(F, P, R2, R5);
    GRID_BAR(9);
    {
        pg8::Gemm g{R2, (const bf16*)(P.ws + WS_W4T), MP, 2048, D}; pg8::StaticOrder S; S.init(MP, 2048, F.G, (int)blockIdx.x);
        EpiRes<true> E{R3, R3, (const float*)(P.ws + WS_ADA) + (size_t)16 * 6144 + 4096, (float*)(P.ws + WS_SS2)};
        MiniRes<true> ME{R3 + (size_t)MP * D, R3 + (size_t)MP * D, (const float*)(P.ws + WS_ADA) + (size_t)16 * 6144 + 4096, (float*)(P.ws + WS_SS2)};
        MINI_EARLY(R2 + (size_t)MP * D, (const bf16*)(P.ws + WS_W4T), 2048, ME);
        pg8::gemm_phase<EpiRes<true>, pg8::StaticOrder, true, true>(F.lds, g, S, E);
        MINI_LATE(R2 + (size_t)MP * D, (const bf16*)(P.ws + WS_W4T), 2048, ME);
    }
    GRID_BAR(10);
    phase_final_norm(F, P, R3);
#ifdef PROBE_MASK
    GRID_BAR(11);
    if (blockIdx.x == 0 && F.tid == 0) { const unsigned long long t0_ = __builtin_amdgcn_s_memrealtime(); while (__builtin_amdgcn_s_memrealtime() - t0_ < pr_acc * PROBE_AMP) __builtin_amdgcn_s_sleep(8); }
#endif
#endif
#if LAST_PHASE < 9
    {
        f32x4* o = (f32x4*)P.out; const f32x4 z = {0.f, 0.f, 0.f, 0.f};
        for (size_t i = (size_t)blockIdx.x * 512 + F.tid; i < OKP / 4; i += (size_t)F.G * 512) o[i] = z;
#if LAST_PHASE < 5
        for (size_t i = OSP / 4 + (size_t)blockIdx.x * 512 + F.tid; i < OUT_TOTAL / 4; i += (size_t)F.G * 512) o[i] = z;
#endif
    }
#endif
}

#undef R0
#undef R1
#undef R2
#undef R3
#undef R4
#undef R5
extern "C" void kernel_launch(void* const* d_in, const int* in_sizes, int n_in, void* d_out, int out_size, void* d_ws, size_t ws_size, hipStream_t stream) {
    static int grid = 0;
    if (grid == 0) {
        if (n_in != 18 || (size_t)out_size != OUT_TOTAL || ws_size < WS_END) { fprintf(stderr, "kernel_launch: unexpected shapes: n_in %d out %d ws %zu (need %zu)\n", n_in, out_size, ws_size, (size_t)WS_END); grid = -1; return; }
        int dev = 0, cus = 0, per_cu = 0;
        if (hipGetDevice(&dev) != hipSuccess || hipDeviceGetAttribute(&cus, hipDeviceAttributeMultiprocessorCount, dev) != hipSuccess) { grid = -1; return; }
        if (hipFuncSetAttribute((const void*)fwd_kernel, hipFuncAttributeMaxDynamicSharedMemorySize, LDS_BYTES) != hipSuccess) { fprintf(stderr, "kernel_launch: hipFuncSetAttribute failed\n"); grid = -1; return; }
        if (hipOccupancyMaxActiveBlocksPerMultiprocessor(&per_cu, (const void*)fwd_kernel, 512, LDS_BYTES) != hipSuccess || per_cu < 1) fprintf(stderr, "kernel_launch: occupancy query reports %d\n", per_cu);
        (void)hipGetLastError();
        grid = cus;
    }
    if (grid < 0) return;
    (void)in_sizes;
    hipMemsetAsync((char*)d_ws + WS_CTL, 0, CTL_ZERO_BYTES, stream);
    Params p{};
    for (int i = 0; i < 18; ++i) p.in[i] = (const float*)d_in[i];
    p.out = (float*)d_out; p.ws = (unsigned char*)d_ws;
    hipLaunchKernelGGL(fwd_kernel, dim3(grid), dim3(512), LDS_BYTES, stream, p);
}
```

```cpp
#include <hip/hip_runtime.h>
#include <cstdio>
#include <cstdint>

#ifndef PROBE_AMP
#define PROBE_AMP 1
#endif
#ifndef LAST_PHASE
#define LAST_PHASE 99
#endif

constexpr int D = 2048;
constexpr int MP = 32768;
constexpr int MS = 128;
constexpr int MV = MP + MS;
constexpr int MT = 33024;
constexpr int SEQ = 4096, DSEQ = 16, PAST = 4096;
constexpr int NH = 16, DH = 128;
constexpr int GH = 4, GDK = 256, GDV = 512, GIN = 6160;
constexpr float EPS = 1e-6f;

constexpr size_t OY = 0;
constexpr size_t OKP = (size_t)MP * D + (size_t)MS * D;
constexpr size_t OVP = OKP + (size_t)MP * D;
constexpr size_t OKS = OVP + (size_t)MP * D;
constexpr size_t OVS = OKS + (size_t)MS * D;
constexpr size_t OSP = OVS + (size_t)MS * D;
constexpr size_t OSS = OSP + (size_t)8 * GH * GDK * GDV;
constexpr size_t OUT_TOTAL = OSS + (size_t)8 * GH * GDK * GDV;

constexpr size_t MiB = 1u << 20;
constexpr size_t WS_CTL = 0, CTL_ZERO_BYTES = 64 * 1024;
constexpr size_t WS_ADA = 1 * MiB;
constexpr size_t WS_WA = 2 * MiB;
constexpr size_t WS_W1T = 4 * MiB;
constexpr size_t WS_W2T = 36 * MiB;
constexpr size_t WS_W3T = 44 * MiB;
constexpr size_t WS_W4T = 68 * MiB;
constexpr size_t WS_EB = 76 * MiB;
constexpr size_t WS_ALR = 79 * MiB;
constexpr size_t WS_AM = 87 * MiB;
constexpr size_t WS_R0 = 104 * MiB;
constexpr size_t RSZ = 129 * MiB;
constexpr size_t WS_KLT = WS_R0 + 6 * RSZ;
constexpr size_t WS_SS2 = WS_KLT + 65 * MiB;
constexpr size_t WS_SSQ = WS_SS2 + 5 * MiB;
constexpr size_t WS_END = WS_SSQ + 17 * MiB;
static_assert((size_t)MT * D * 2 == RSZ, "region size");
constexpr int CW_BAR = 1024;

#define LAS __attribute__((address_space(3)))
typedef unsigned short bf16;
typedef short bf16x8 __attribute__((ext_vector_type(8)));
typedef short s16x4 __attribute__((ext_vector_type(4)));
typedef float f32x2 __attribute__((ext_vector_type(2)));
typedef float f32x4 __attribute__((ext_vector_type(4)));
typedef float f32x16 __attribute__((ext_vector_type(16)));
typedef unsigned u32x2 __attribute__((ext_vector_type(2)));
typedef unsigned u32x4 __attribute__((ext_vector_type(4)));
typedef __bf16 bf16x2_t __attribute__((ext_vector_type(2)));
#define LDS_WAIT() asm volatile("s_waitcnt lgkmcnt(0)" ::: "memory")
#define DI __device__ __forceinline__
#define LDS_BARRIER() do { asm volatile("s_waitcnt lgkmcnt(0)" ::: "memory"); __builtin_amdgcn_s_barrier(); asm volatile("" ::: "memory"); } while (0)

DI unsigned pk2(float lo, float hi) { f32x2 v = {lo, hi}; bf16x2_t b = __builtin_convertvector(v, bf16x2_t); return __builtin_bit_cast(unsigned, b); }
DI float bf2f(unsigned short b) { return __uint_as_float(((unsigned)b) << 16); }
DI float bflo(unsigned w) { return __uint_as_float(w << 16); }
DI float bfhi(unsigned w) { return __uint_as_float(w & 0xffff0000u); }
DI float wave_sum(float v) {
#pragma unroll
    for (int o = 1; o < 64; o <<= 1) v += __shfl_xor(v, o);
    return v;
}
template <int CTRL> DI float dppf(float v) { return __builtin_bit_cast(float, __builtin_amdgcn_update_dpp(0, __builtin_bit_cast(int, v), CTRL, 0xF, 0xF, true)); }
DI float row16_sum(float v) {
    v += dppf<0xB1>(v); v += dppf<0x4E>(v); v += dppf<0x141>(v); v += dppf<0x140>(v); return v;
}
DI float silu_f(float x) { return x / (1.0f + __expf(-x)); }

#define XB_TMO      128
#define XB_XCNT(j)  (256  + 64 * (j))
#define XB_XSUB(j)  (1280 + 64 * (j))
#define XB_XGEN(j)  (2304 + 64 * (j))
#define XB_TOP      3328
#define XB_TOPGEN   3392
#define XCD_BAR_WORDS 3456
#define XB_SPIN_CAP (1u << 22)

DI unsigned xb_ld(unsigned* p)              { return __hip_atomic_load(p, __ATOMIC_RELAXED, __HIP_MEMORY_SCOPE_AGENT); }
DI unsigned xb_add(unsigned* p, unsigned v) { return __hip_atomic_fetch_add(p, v, __ATOMIC_RELAXED, __HIP_MEMORY_SCOPE_AGENT); }
DI unsigned xb_xcc_id() { return (unsigned)__builtin_amdgcn_s_getreg((3 << 11) | 20) & 0xFu; }
#define XB_SPIN(cond, bar) do { unsigned _sp = 0; while (cond) { __builtin_amdgcn_s_sleep(1); \
    if ((++_sp & 255u) == 0u) { if (xb_ld(&(bar)[XB_TMO])) break; if (_sp > XB_SPIN_CAP) { atomicAdd(&(bar)[XB_TMO], 1u); break; } } } } while (0)

struct XcdBarrier { unsigned* bar; unsigned x; volatile LAS unsigned* st; };

DI XcdBarrier xcd_barrier_post(unsigned* bar, volatile LAS unsigned* st) {
    XcdBarrier b; b.bar = bar; b.x = xb_xcc_id(); b.st = st;
    if (threadIdx.x == 0) (void)xb_add(&bar[XB_XCNT(b.x)], 1u);
    return b;
}
DI void xcd_barrier_complete(unsigned* bar, unsigned x, unsigned& nloc, unsigned& nx) {
    const unsigned G = gridDim.x * gridDim.y * gridDim.z;
    unsigned sum, cnt, mine, sp = 0u;
    for (;;) {
        sum = 0u; cnt = 0u; mine = 0u;
#pragma unroll
        for (unsigned j = 0; j < 16; ++j) { const unsigned c = xb_ld(&bar[XB_XCNT(j)]); sum += c; cnt += (c > 0u) ? 1u : 0u; mine = (j == x) ? c : mine; }
        if (sum == G) break;
        __builtin_amdgcn_s_sleep(1);
        if ((++sp & 255u) == 0u) { if (xb_ld(&bar[XB_TMO])) break; if (sp > XB_SPIN_CAP) { atomicAdd(&bar[XB_TMO], 1u); break; } }
    }
    nloc = mine > 0u ? mine : 1u; nx = cnt > 0u ? cnt : 1u;
}
DI void xcd_barrier(const XcdBarrier& b) {
    asm volatile("s_waitcnt vmcnt(0)" ::: "memory");
    __syncthreads();
    if (threadIdx.x == 0) {
        unsigned* bar = b.bar;
        __builtin_amdgcn_s_waitcnt(0);
        unsigned nloc = b.st[0], nx = b.st[1];
        if (nloc == 0u) { xcd_barrier_complete(bar, b.x, nloc, nx); b.st[0] = nloc; b.st[1] = nx; }
        const unsigned old = xb_add(&bar[XB_XSUB(b.x)], 1u);
        const unsigned gen = old / nloc;
        if (old + 1u == (gen + 1u) * nloc) {
            __builtin_amdgcn_fence(__ATOMIC_RELEASE, "agent");
            asm volatile("s_waitcnt vmcnt(0)" ::: "memory");
            const unsigned og = xb_add(&bar[XB_TOP], 1u);
            const unsigned tg = og / nx;
            if (og + 1u == (tg + 1u) * nx) xb_add(&bar[XB_TOPGEN], 1u);
            else XB_SPIN(xb_ld(&bar[XB_TOPGEN]) == tg, bar);
            __builtin_amdgcn_fence(__ATOMIC_ACQUIRE, "agent");
            xb_add(&bar[XB_XGEN(b.x)], 1u);
            asm volatile("s_waitcnt vmcnt(0)" ::: "memory");
        } else {
            XB_SPIN(xb_ld(&bar[XB_XGEN(b.x)]) == gen, bar);
            __builtin_amdgcn_fence(__ATOMIC_ACQUIRE, "agent");
            asm volatile("s_waitcnt vmcnt(0)" ::: "memory");
        }
    }
    __syncthreads();
}

namespace pg8 {
#define PG8_LAS __attribute__((address_space(3)))
constexpr int BM = 256, BK = 64, HALF = 128, HTB = HALF * BK * 2, STAGE_BYTES = 8 * HTB, NXCD = 8, WGM = 8;
__host__ __device__ __forceinline__ int lds_byte(int r, int c) { const int st = (r >> 4) * 2 + (c >> 5), rr = r & 15, cc = c & 31, ob = rr * 64 + cc * 2; return st * 1024 + (ob ^ (((ob >> 9) & 1) << 5)); }
__host__ __device__ __forceinline__ void stage_rc(int b, int& R, int& C) { const int st = b / 1024, sb = b % 1024, swz = sb ^ (((sb >> 9) & 1) << 5); R = (st >> 1) * 16 + swz / 64; C = (st & 1) * 32 + (swz % 64) / 2; }
__host__ __device__ __forceinline__ int perm32(int rho) { const int n = rho >> 4, i = rho & 15; return 8 * (i >> 2) + 4 * n + (i & 3); }
struct Unit { int pm, pn; };
struct Gemm { const bf16* A; const bf16* Bt; int M, N, K; };
struct StaticOrder {
    int nM, nN, nwg, G, c, wgm;
    __host__ __device__ void init(int M, int N, int G_, int c_, int wgm_ = 4) { nM = M / BM; nN = N / BM; nwg = nM * nN; G = G_; c = c_; wgm = wgm_; }
    __host__ __device__ bool next(int i, Unit& u) const {
        const long L = (long)i * G + c; if (L >= nwg) return false;
        int wgid = (int)L; { const int q = nwg / NXCD, r = nwg % NXCD, xcd = wgid % NXCD, off = wgid / NXCD; wgid = (xcd < r ? xcd * (q + 1) : r * (q + 1) + (xcd - r) * q) + off; }
        const int nig = wgm * nN, gid = wgid / nig, fm = gid * wgm, gsz = (nM - fm) < wgm ? (nM - fm) : wgm;
        u.pm = fm + ((wgid % nig) % gsz); u.pn = (wgid % nig) / gsz; return true;
    }
    __device__ __forceinline__ void a_ready(const Unit&) const {}
    __device__ __forceinline__ void done(const Unit&) const {}
};
template <class Epi, class Sched, bool ALIGN_EPI = false, bool SP2 = false>
__device__ __forceinline__ void gemm_phase(PG8_LAS unsigned char* lds, const Gemm g, const Sched& S, const Epi& E) {
    int tid = threadIdx.x; asm volatile("" : "+v"(tid));
    const int wid = __builtin_amdgcn_readfirstlane(tid >> 6), lane = tid & 63, wr = wid >> 2, wc = wid & 3, fr = lane & 15, fq = lane >> 4;
    const int K = g.K, nt = K / BK;
    unsigned voffA[2], voffB[2];
#pragma unroll
    for (int i = 0; i < 2; ++i) { int R, C; stage_rc(tid * 16 + i * 8192, R, C); const int Rb = Epi::PERM ? ((R & ~31) + perm32(R & 31)) : R;
        voffA[i] = (unsigned)(R * K + C) * 2u; voffB[i] = (unsigned)(Rb * K + C) * 2u; }
    const size_t kstep = (size_t)(BK * 2);
    const size_t hstep = (size_t)HALF * K * 2;
    const size_t tstep = 2 * hstep;
    const unsigned ldsw = (unsigned)wid * 1024u;
    const int aoff = lds_byte(wr * 64 + fr, fq * 8), boff = lds_byte(wc * 32 + fr, fq * 8);
#define PG8_SA(b, h) (((b) * 2 + (h)) * HTB)
#define PG8_SB(b, h) ((4 + (b) * 2 + (h)) * HTB)
#define PG8_STAGE(bufoff, gbase, voff) do { _Pragma("unroll") for (int _i = 0; _i < 2; ++_i) \
        __builtin_amdgcn_global_load_lds((const unsigned*)((const char*)(gbase) + (voff)[_i]), (PG8_LAS unsigned*)(lds + (bufoff) + ldsw + _i * 8192), 16, 0, 0); } while (0)
#define PG8_LDA(dst, b, h) do { _Pragma("unroll") for (int m = 0; m < 4; ++m) _Pragma("unroll") for (int k = 0; k < 2; ++k) dst[m][k] = *(const PG8_LAS bf16x8*)(lds + PG8_SA(b, h) + aoff + m * 2048 + k * 1024); } while (0)
#define PG8_LDB(dst, b, h) do { _Pragma("unroll") for (int n = 0; n < 2; ++n) _Pragma("unroll") for (int k = 0; k < 2; ++k) dst[n][k] = *(const PG8_LAS bf16x8*)(lds + PG8_SB(b, h) + boff + n * 2048 + k * 1024); } while (0)
#define PG8_MMA(ai, bj, At, Bt) do { __builtin_amdgcn_s_setprio(1); _Pragma("unroll") for (int m = 0; m < 4; ++m) _Pragma("unroll") for (int n = 0; n < 2; ++n) _Pragma("unroll") for (int k = 0; k < 2; ++k) \
        acc[ai][bj][m][n] = __builtin_amdgcn_mfma_f32_16x16x32_bf16(Bt[n][k], At[m][k], acc[ai][bj][m][n], 0, 0, 0); __builtin_amdgcn_s_setprio(0); } while (0)
#define PG8_WAIT_V(n) asm volatile("s_waitcnt vmcnt(" #n ")" ::: "memory")
#define PG8_WAIT_L(n) asm volatile("s_waitcnt lgkmcnt(" #n ")" ::: "memory")
#define PG8_BAR __builtin_amdgcn_s_barrier()
#define PG8_SCHED __builtin_amdgcn_sched_barrier(0)
    Unit cur, nxt; int ui = 0;
    if (!S.next(0, cur)) return;
    f32x4 acc[2][2][4][2];
#pragma unroll
    for (int a = 0; a < 2; ++a)
#pragma unroll
        for (int b = 0; b < 2; ++b)
#pragma unroll
            for (int m = 0; m < 4; ++m)
#pragma unroll
                for (int n = 0; n < 2; ++n) acc[a][b][m][n] = (f32x4){0.f, 0.f, 0.f, 0.f};
    bf16x8 At[4][2], B0[2][2], B1[2][2];
    const char* cA = (const char*)g.A + (size_t)cur.pm * tstep; const char* cB = (const char*)g.Bt + (size_t)cur.pn * tstep;
    S.a_ready(cur);
    if constexpr (SP2) {
        PG8_STAGE(PG8_SB(0, 0), cB, voffB); PG8_STAGE(PG8_SB(0, 1), cB + hstep, voffB); PG8_STAGE(PG8_SA(0, 0), cA, voffA); PG8_STAGE(PG8_SA(0, 1), cA + hstep, voffA);
        if (wr == 1) PG8_BAR;
        PG8_WAIT_V(2); PG8_BAR;
        PG8_STAGE(PG8_SB(1, 0), cB + kstep, voffB); PG8_STAGE(PG8_SA(1, 0), cA + kstep, voffA); PG8_STAGE(PG8_SB(1, 1), cB + hstep + kstep, voffB);
        PG8_WAIT_V(6); PG8_BAR;
    } else {
        PG8_STAGE(PG8_SB(0, 0), cB, voffB); PG8_STAGE(PG8_SA(0, 0), cA, voffA); PG8_STAGE(PG8_SB(0, 1), cB + hstep, voffB); PG8_STAGE(PG8_SA(0, 1), cA + hstep, voffA);
        if (wr == 1) PG8_BAR;
        PG8_WAIT_V(4); PG8_BAR;
        PG8_STAGE(PG8_SB(1, 0), cB + kstep, voffB); PG8_STAGE(PG8_SA(1, 0), cA + kstep, voffA); PG8_STAGE(PG8_SB(1, 1), cB + hstep + kstep, voffB);
        PG8_WAIT_V(6); PG8_BAR;
    }
    for (;;) {
        const bool has_next = S.next(ui + 1, nxt);
        const char* nA = has_next ? (const char*)g.A + (size_t)nxt.pm * tstep : cA; const char* nB = has_next ? (const char*)g.Bt + (size_t)nxt.pn * tstep : cB;
        for (int t = 0; t < nt; t += 2) {
            const bool last = (t == nt - 2);
            const char* a1 = cA + (size_t)(t + 1) * kstep;
            const char* a2 = last ? nA : cA + (size_t)(t + 2) * kstep; const char* b2 = last ? nB : cB + (size_t)(t + 2) * kstep;
            const char* a3 = a2 + kstep; const char* b3 = b2 + kstep;
            if (last && has_next) S.a_ready(nxt);
            if constexpr (SP2) {
            PG8_LDB(B0, 0, 0); PG8_LDB(B1, 0, 1); PG8_SCHED; PG8_LDA(At, 0, 0); PG8_STAGE(PG8_SA(1, 1), a1 + hstep, voffA);
            PG8_WAIT_V(8); PG8_WAIT_L(0); PG8_BAR; PG8_MMA(0, 0, At, B0); PG8_MMA(0, 1, At, B1); PG8_BAR; PG8_SCHED;
            PG8_LDA(At, 0, 1); PG8_STAGE(PG8_SB(0, 0), b2, voffB); PG8_STAGE(PG8_SB(0, 1), b2 + hstep, voffB); PG8_STAGE(PG8_SA(0, 0), a2, voffA);
            PG8_WAIT_V(8); PG8_WAIT_L(0); PG8_BAR; PG8_MMA(1, 0, At, B0); PG8_MMA(1, 1, At, B1); PG8_BAR; PG8_SCHED;
            PG8_LDB(B0, 1, 0); PG8_LDB(B1, 1, 1); PG8_SCHED; PG8_LDA(At, 1, 0); PG8_STAGE(PG8_SA(0, 1), a2 + hstep, voffA);
            PG8_WAIT_V(8); PG8_WAIT_L(0); PG8_BAR; PG8_MMA(0, 0, At, B0); PG8_MMA(0, 1, At, B1); PG8_BAR; PG8_SCHED;
            PG8_LDA(At, 1, 1); PG8_STAGE(PG8_SB(1, 0), b3, voffB); PG8_STAGE(PG8_SB(1, 1), b3 + hstep, voffB); PG8_STAGE(PG8_SA(1, 0), a3, voffA);
            PG8_WAIT_V(8); PG8_WAIT_L(0); PG8_BAR; PG8_MMA(1, 0, At, B0); PG8_MMA(1, 1, At, B1); PG8_BAR; PG8_SCHED;
            } else {
            PG8_LDB(B0, 0, 0); PG8_SCHED; PG8_LDA(At, 0, 0); PG8_STAGE(PG8_SA(1, 1), a1 + hstep, voffA);
            PG8_WAIT_L(8); PG8_BAR; PG8_WAIT_L(0); PG8_MMA(0, 0, At, B0); PG8_BAR; PG8_SCHED;
            PG8_LDB(B1, 0, 1); PG8_STAGE(PG8_SB(0, 0), b2, voffB);
            PG8_BAR; PG8_WAIT_L(0); PG8_MMA(0, 1, At, B1); PG8_BAR;
            PG8_LDA(At, 0, 1); PG8_STAGE(PG8_SA(0, 0), a2, voffA);
            PG8_BAR; PG8_WAIT_L(0); PG8_MMA(1, 0, At, B0); PG8_BAR; PG8_SCHED;
            PG8_STAGE(PG8_SB(0, 1), b2 + hstep, voffB);
            PG8_WAIT_V(6); PG8_BAR; PG8_MMA(1, 1, At, B1); PG8_BAR;
            PG8_LDB(B0, 1, 0); PG8_SCHED; PG8_LDA(At, 1, 0); PG8_STAGE(PG8_SA(0, 1), a2 + hstep, voffA);
            PG8_WAIT_L(8); PG8_BAR; PG8_WAIT_L(0); PG8_MMA(0, 0, At, B0); PG8_BAR; PG8_SCHED;
            PG8_LDB(B1, 1, 1); PG8_STAGE(PG8_SB(1, 0), b3, voffB);
            PG8_BAR; PG8_WAIT_L(0); PG8_MMA(0, 1, At, B1); PG8_BAR;
            PG8_LDA(At, 1, 1); PG8_STAGE(PG8_SA(1, 0), a3, voffA);
            PG8_BAR; PG8_WAIT_L(0); PG8_MMA(1, 0, At, B0); PG8_BAR; PG8_SCHED;
            PG8_STAGE(PG8_SB(1, 1), b3 + hstep, voffB);
            PG8_WAIT_V(6); PG8_BAR; PG8_MMA(1, 1, At, B1); PG8_BAR;
            }
        }
        if constexpr (ALIGN_EPI) { if (wr == 0) PG8_BAR; }
        E(acc, cur, wr, wc, fr, fq); S.done(cur);
        if (!has_next) break;
#pragma unroll
        for (int a = 0; a < 2; ++a)
#pragma unroll
            for (int b = 0; b < 2; ++b)
#pragma unroll
                for (int m = 0; m < 4; ++m)
#pragma unroll
                    for (int n = 0; n < 2; ++n) acc[a][b][m][n] = (f32x4){0.f, 0.f, 0.f, 0.f};
        cur = nxt; cA = nA; cB = nB; ++ui;
        if constexpr (ALIGN_EPI) { if (wr == 1) PG8_BAR; }
    }
    PG8_WAIT_V(0);
    if constexpr (!ALIGN_EPI) { if (wr == 0) PG8_BAR; }
    PG8_BAR;
#undef PG8_SA
#undef PG8_SB
#undef PG8_STAGE
#undef PG8_LDA
#undef PG8_LDB
#undef PG8_MMA
#undef PG8_WAIT_V
#undef PG8_WAIT_L
#undef PG8_BAR
#undef PG8_SCHED
}
}

struct Epi1 {
    static constexpr bool PERM = true;
    unsigned char* wsb; float qscale;
    DI void operator()(const f32x4 (&acc)[2][2][4][2], const pg8::Unit& u, int wr, int wc, int fr, int fq) const {
        const int t = u.pn >> 3, colt = (u.pn & 7) * 256;
        const int row0 = u.pm * 256 + wr * 64 + fr, col0 = colt + wc * 32 + 8 * fq;
        bf16* bo = (bf16*)(wsb + WS_R0 + (size_t)(1 + t) * RSZ);
#pragma unroll
        for (int ai = 0; ai < 2; ++ai)
#pragma unroll
            for (int m = 0; m < 4; ++m) {
                const int row = row0 + ai * 128 + m * 16;
#pragma unroll
                for (int bj = 0; bj < 2; ++bj) {
                    f32x4 v0 = acc[ai][bj][m][0], v1 = acc[ai][bj][m][1];
                    const int col = col0 + bj * 128;
                    if (t == 0) { v0 = v0 * qscale; v1 = v1 * qscale; }
                    if (t == 3) {
#pragma unroll
                        for (int j = 0; j < 4; ++j) { v0[j] = silu_f(v0[j]); v1[j] = silu_f(v1[j]); }
                    }
                    u32x4 w; w.x = pk2(v0[0], v0[1]); w.y = pk2(v0[2], v0[3]); w.z = pk2(v1[0], v1[1]); w.w = pk2(v1[2], v1[3]);
                    __builtin_nontemporal_store(w, (u32x4*)(bo + (size_t)row * D + col));
                }
            }
    }
};

struct Params {
    const float* in[18];
    float* out;
    unsigned char* ws;
};

typedef const __attribute__((address_space(4))) Params CParams;

struct Frame {
    LAS unsigned char* lds;
    int tid, lane, wave, vcu, G;
};

constexpr int LDS_BYTES = 160 * 1024 - 256;
constexpr int LDS_MISC = LDS_BYTES - 64;


template <class ME>
DI void mini_gemm(const Frame& F, const bf16* A, const bf16* Bt, const ME& E, int first, int stride, int limit) {
    LAS unsigned char* lds = F.lds;
    for (int tile = first; tile < limit; tile += stride) {
        int tid = F.tid; asm volatile("" : "+v"(tid));
        const int lane = tid & 63, i16 = lane & 15, g4 = lane >> 4, w = F.wave;
        const int rt = tile & 3, cb = tile >> 2;
        f32x4 acc[2][4];
#pragma unroll
        for (int ri = 0; ri < 2; ++ri)
#pragma unroll
            for (int ci = 0; ci < 4; ++ci) acc[ri][ci] = (f32x4){0.f, 0.f, 0.f, 0.f};
        const bf16* ap = A + (size_t)(32 * rt + i16) * D + 256 * w + 8 * g4;
        const bf16* bp = Bt + (size_t)(64 * cb + i16) * D + 256 * w + 8 * g4;
#pragma unroll
        for (int ks = 0; ks < 8; ++ks) {
            bf16x8 a[2], b[4];
#pragma unroll
            for (int ri = 0; ri < 2; ++ri) a[ri] = *(const bf16x8*)(ap + (size_t)(16 * ri) * D + 32 * ks);
#pragma unroll
            for (int ci = 0; ci < 4; ++ci) b[ci] = *(const bf16x8*)(bp + (size_t)(16 * ci) * D + 32 * ks);
#pragma unroll
            for (int ri = 0; ri < 2; ++ri)
#pragma unroll
                for (int ci = 0; ci < 4; ++ci) acc[ri][ci] = __builtin_amdgcn_mfma_f32_16x16x32_bf16(a[ri], b[ci], acc[ri][ci], 0, 0, 0);
        }
        LAS float* part = (LAS float*)lds + w * 2048;
#pragma unroll
        for (int ri = 0; ri < 2; ++ri)
#pragma unroll
            for (int ci = 0; ci < 4; ++ci)
#pragma unroll
                for (int e = 0; e < 4; ++e) part[(16 * ri + 4 * g4 + e) * 64 + 16 * ci + i16] = acc[ri][ci][e];
        LDS_BARRIER();
        {
            const int row = tid >> 4, c4 = (tid & 15) * 4;
            f32x4 v = {0.f, 0.f, 0.f, 0.f};
#pragma unroll
            for (int wv = 0; wv < 8; ++wv) v += *(const LAS f32x4*)((const LAS float*)lds + wv * 2048 + row * 64 + c4);
            E(32 * rt + row, 64 * cb + c4, cb, v);
        }
        LDS_BARRIER();
    }
}
struct Mini1 {
    unsigned char* wsb; float qscale;
    DI void operator()(int srow, int col, int cb, f32x4 v) const {
        (void)cb;
        const int t = col >> 11, c = col & 2047;
        if (t == 0) v = v * qscale;
        if (t == 3) { v[0] = silu_f(v[0]); v[1] = silu_f(v[1]); v[2] = silu_f(v[2]); v[3] = silu_f(v[3]); }
        bf16* bo = (bf16*)(wsb + WS_R0 + (size_t)(1 + t) * RSZ);
        *(u32x2*)(bo + (size_t)(MP + srow) * D + c) = (u32x2){pk2(v[0], v[1]), pk2(v[2], v[3])};
    }
};
struct Mini3 {
    unsigned char* wsb;
    DI void operator()(int srow, int col, int cb, f32x4 v) const {
        (void)cb;
        const int t = col >> 11, c = col & 2047;
        if (t == 2) { v[0] = silu_f(v[0]); v[1] = silu_f(v[1]); v[2] = silu_f(v[2]); v[3] = silu_f(v[3]); }
        bf16* bo = (bf16*)(wsb + WS_R0 + (size_t)(t == 0 ? 1 : 3 + t) * RSZ);
        *(u32x2*)(bo + (size_t)(MP + srow) * D + c) = (u32x2){pk2(v[0], v[1]), pk2(v[2], v[3])};
    }
};
template <bool XBF> struct MiniRes {
    const void* xin; bf16* out; const float* gate; float* ss2;
    DI void operator()(int srow, int col, int cb, f32x4 v) const {
        const float* gp = gate + (size_t)(8 + (srow >> 4)) * 6144;
        f32x4 x;
        if (XBF) { const u32x2 xv = *(const u32x2*)((const bf16*)xin + (size_t)srow * D + col); x = (f32x4){bflo(xv.x), bfhi(xv.x), bflo(xv.y), bfhi(xv.y)}; }
        else x = *(const f32x4*)((const float*)xin + (size_t)srow * D + col);
        const f32x4 y = x + *(const f32x4*)(gp + col) * v;
        *(u32x2*)(out + (size_t)srow * D + col) = (u32x2){pk2(y[0], y[1]), pk2(y[2], y[3])};
        const float sq = row16_sum((y[0] * y[0] + y[1] * y[1]) + (y[2] * y[2] + y[3] * y[3]));
        if ((threadIdx.x & 15) == 0) ss2[(size_t)(MP + srow) * 32 + cb] = sq;
    }
};

DI void p0_transpose_item(const float* W, int ldw, int K, bf16* WT, LAS float* scr, int kb, int nb, int lane) {
    const int k0 = 64 * kb, n0 = 32 * nb;
    float wv[32];
#pragma unroll
    for (int i = 0; i < 32; ++i) wv[i] = W[(size_t)(k0 + 2 * i + (lane >> 5)) * ldw + n0 + (lane & 31)];
#pragma unroll
    for (int i = 0; i < 32; ++i) scr[(2 * i + (lane >> 5)) * 33 + (lane & 31)] = wv[i];
    LDS_WAIT(); asm volatile("" ::: "memory");
    const int c = lane & 7;
#pragma unroll
    for (int j = 0; j < 4; ++j) { const int n = (lane >> 3) + 8 * j; const LAS float* s = scr + (8 * c) * 33 + n;
        u32x4 o; o.x = pk2(s[0 * 33], s[1 * 33]); o.y = pk2(s[2 * 33], s[3 * 33]); o.z = pk2(s[4 * 33], s[5 * 33]); o.w = pk2(s[6 * 33], s[7 * 33]);
        *(u32x4*)(WT + (size_t)(n0 + n) * K + k0 + 8 * c) = o; }
    LDS_WAIT(); asm volatile("" ::: "memory");
}

DI void phase0_transposes(const Frame& F, CParams& P) {
    unsigned char* ws = P.ws;
    {
        LAS float* scr = (LAS float*)(F.lds + F.wave * 8704);
        const int gw = F.vcu * 8 + F.wave, NGW = F.G * 8;
        constexpr int I1 = 32 * 256, I2 = 32 * 64, I3 = 32 * 192, I4 = 32 * 64;
        for (int it = gw; it < I1 + I2 + I3 + I4; it += NGW) {
            int r = it;
            if (r < I1) { p0_transpose_item(P.in[10], 8192, D, (bf16*)(ws + WS_W1T), scr, r / 256, r % 256, F.lane); continue; } r -= I1;
            if (r < I2) { p0_transpose_item(P.in[11], 2048, D, (bf16*)(ws + WS_W2T), scr, r / 64, r % 64, F.lane); continue; } r -= I2;
            if (r < I3) { p0_transpose_item(P.in[12], GIN, D, (bf16*)(ws + WS_W3T), scr, r / 192, r % 192, F.lane); continue; } r -= I3;
            p0_transpose_item(P.in[16], 2048, D, (bf16*)(ws + WS_W4T), scr, r / 64, r % 64, F.lane);
        }
        bf16* WA = (bf16*)(ws + WS_WA);
        for (int idx = blockIdx.x * 512 + F.tid; idx < 16 * 2048; idx += F.G * 512) { const int r = idx >> 11, k = idx & 2047; WA[idx] = (bf16)(pk2(P.in[12][(size_t)k * GIN + 6144 + r], 0.f) & 0xffffu); }
    }
}
DI void phase0_ada(const Frame& F, CParams& P) {
    unsigned char* ws = P.ws;
    if (blockIdx.x < 192) {
        LAS float* cs = (LAS float*)F.lds;
        for (int idx = F.tid; idx < 16 * 2048; idx += 512) { const int bi = idx >> 11, k = idx & 2047; cs[k * 16 + bi] = bi < 8 ? P.in[5][bi * 2048 + k] : P.in[6][(bi - 8) * 2048 + k]; }
        __syncthreads();
        const int l = blockIdx.x / 96, grp = blockIdx.x % 96, n = grp * 64 + F.lane;
        const float* w = P.in[7] + (size_t)l * 2048 * 6144 + n;
        float acc[16];
#pragma unroll
        for (int i = 0; i < 16; ++i) acc[i] = 0.f;
        const int kbeg = F.wave * 256;
#pragma unroll 8
        for (int k = kbeg; k < kbeg + 256; ++k) {
            const float wv = w[(size_t)k * 6144];
#pragma unroll
            for (int j = 0; j < 4; ++j) { const f32x4 cv = *(const LAS f32x4*)(cs + k * 16 + 4 * j);
                acc[4 * j + 0] += cv[0] * wv; acc[4 * j + 1] += cv[1] * wv; acc[4 * j + 2] += cv[2] * wv; acc[4 * j + 3] += cv[3] * wv; }
        }
        __syncthreads();
        LAS float* red = (LAS float*)F.lds;
#pragma unroll
        for (int i = 0; i < 16; ++i) red[(F.wave * 16 + i) * 64 + F.lane] = acc[i];
        __syncthreads();
        float* ADA = (float*)(ws + WS_ADA);
        for (int o = F.tid; o < 1024; o += 512) { const int bi = o >> 6, ln = o & 63; float s = P.in[8][l * 6144 + grp * 64 + ln];
#pragma unroll
            for (int wv = 0; wv < 8; ++wv) s += red[(wv * 16 + bi) * 64 + ln];
            ADA[(size_t)(l * 16 + bi) * 6144 + grp * 64 + ln] = s; }
    }
}

DI void phase_norm_mod_generic(const Frame& F, CParams& P, int l, bf16* H) {
    const int gw = F.vcu * 8 + F.wave, NGW = F.G * 8;
    const float* ADA = (const float*)(P.ws + WS_ADA) + (size_t)l * 16 * 6144;
    const float* ng = P.in[9] + l * D;
    for (int m = gw; m < MT; m += NGW) {
        u32x2* o8 = (u32x2*)(H + (size_t)m * D) + F.lane;
        if (m >= MV) {
#pragma unroll
            for (int j = 0; j < 8; ++j) o8[64 * j] = (u32x2){0u, 0u};
            continue;
        }
        const float* xrow = l == 0 ? (m < MP ? P.in[0] + (size_t)m * D : P.in[1] + (size_t)(m - MP) * D) : P.out + OY + (size_t)m * D;
        const int ai = m < MP ? (m >> 12) : 8 + ((m - MP) >> 4);
        const float* sh = ADA + (size_t)ai * 6144, *sc = sh + 2048;
        const f32x4* xr = (const f32x4*)xrow + F.lane;
        f32x4 v[8]; float s = 0.f;
#pragma unroll
        for (int j = 0; j < 8; ++j) { v[j] = xr[64 * j]; s += (v[j].x * v[j].x + v[j].y * v[j].y) + (v[j].z * v[j].z + v[j].w * v[j].w); }
        const float rstd = 1.0f / sqrtf(wave_sum(s) * (1.0f / D) + EPS);
#pragma unroll
        for (int j = 0; j < 8; ++j) {
            const int c = 4 * F.lane + 256 * j;
            const f32x4 gg = *(const f32x4*)(ng + c), s1 = *(const f32x4*)(sc + c), s0 = *(const f32x4*)(sh + c);
            const f32x4 y = (v[j] * rstd) * gg * (s1 + 1.0f) + s0;
            o8[64 * j] = (u32x2){pk2(y.x, y.y), pk2(y.z, y.w)};
        }
    }
}

constexpr int P1_GM = 96 * 1024, P1_SH = P1_GM + 8192;
DI void p1_tables(const Frame& F, CParams& P, int ai) {
    const float* ADA = (const float*)(P.ws + WS_ADA) + (size_t)ai * 6144;
    const float* ng = P.in[9];
    const int c = 4 * F.tid;
    const f32x4 g = *(const f32x4*)(ng + c), sc = *(const f32x4*)(ADA + 2048 + c), sh = *(const f32x4*)(ADA + c);
    *(LAS f32x4*)(F.lds + P1_GM + c * 4) = g * (sc + 1.0f); *(LAS f32x4*)(F.lds + P1_SH + c * 4) = sh;
}
DI void p1_rows(const Frame& F, const float* xbase, bf16* hbase, int nrows) {
    const int lane = F.lane;
    f32x4 vn[8];
    { const f32x4* xr = (const f32x4*)xbase + lane;
#pragma unroll
      for (int j = 0; j < 8; ++j) vn[j] = xr[64 * j]; }
    for (int i = 0; i < nrows; ++i) {
        f32x4 v[8]; float s = 0.f;
#pragma unroll
        for (int j = 0; j < 8; ++j) { v[j] = vn[j]; s += (v[j].x * v[j].x + v[j].y * v[j].y) + (v[j].z * v[j].z + v[j].w * v[j].w); }
        if (i + 1 < nrows) { const f32x4* xr = (const f32x4*)(xbase + (size_t)(i + 1) * D) + lane;
#pragma unroll
            for (int j = 0; j < 8; ++j) vn[j] = xr[64 * j]; }
        const float rstd = 1.0f / sqrtf(wave_sum(s) * (1.0f / D) + EPS);
        u32x2* o8 = (u32x2*)(hbase + (size_t)i * D) + lane;
#pragma unroll
        for (int j = 0; j < 8; ++j) {
            const int c = 4 * lane + 256 * j;
            const f32x4 gm = *(const LAS f32x4*)(F.lds + P1_GM + c * 4), s0 = *(const LAS f32x4*)(F.lds + P1_SH + c * 4);
            const f32x4 y = (v[j] * rstd) * gm + s0;
            o8[64 * j] = (u32x2){pk2(y.x, y.y), pk2(y.z, y.w)};
        }
    }
}
DI void phase_norm_mod(const Frame& F, CParams& P, int l, bf16* H) {
    if (F.G != 256 || l != 0) { phase_norm_mod_generic(F, P, l, H); return; }
    const int v = F.vcu, w = F.wave;
    p1_tables(F, P, v >> 5);
    __syncthreads();
    p1_rows(F, P.in[0] + ((size_t)128 * v + 16 * w) * D, H + ((size_t)128 * v + 16 * w) * D, 16);
    if (v < 8) {
        __syncthreads();
        p1_tables(F, P, 8 + v);
        __syncthreads();
        p1_rows(F, P.in[1] + ((size_t)16 * v + 2 * w) * D, H + ((size_t)MP + 16 * v + 2 * w) * D, 2);
    }
}

struct Epi3 {
    static constexpr bool PERM = true;
    unsigned char* wsb;
    DI void operator()(const f32x4 (&acc)[2][2][4][2], const pg8::Unit& u, int wr, int wc, int fr, int fq) const {
        const int t = u.pn >> 3, colt = (u.pn & 7) * 256;
        const int row0 = u.pm * 256 + wr * 64 + fr, col0 = colt + wc * 32 + 8 * fq;
        bf16* bo = (bf16*)(wsb + WS_R0 + (size_t)(t == 0 ? 1 : 3 + t) * RSZ);
#pragma unroll
        for (int ai = 0; ai < 2; ++ai)
#pragma unroll
            for (int m = 0; m < 4; ++m) {
                const int row = row0 + ai * 128 + m * 16;
#pragma unroll
                for (int bj = 0; bj < 2; ++bj) {
                    f32x4 v0 = acc[ai][bj][m][0], v1 = acc[ai][bj][m][1];
                    const int col = col0 + bj * 128;
                    if (t == 2) {
#pragma unroll
                        for (int j = 0; j < 4; ++j) { v0[j] = silu_f(v0[j]); v1[j] = silu_f(v1[j]); }
                    }
                    u32x4 w; w.x = pk2(v0[0], v0[1]); w.y = pk2(v0[2], v0[3]); w.z = pk2(v1[0], v1[1]); w.w = pk2(v1[2], v1[3]);
                    __builtin_nontemporal_store(w, (u32x4*)(bo + (size_t)row * D + col));
                }
            }
    }
};
template <bool XBF> struct EpiRes {
    static constexpr bool PERM = true;
    const void* xin; bf16* out; const float* gate; float* ss2;
    DI void operator()(const f32x4 (&acc)[2][2][4][2], const pg8::Unit& u, int wr, int wc, int fr, int fq) const {
        const int row0 = u.pm * 256 + wr * 64 + fr, col0 = u.pn * 256 + wc * 32 + 8 * fq;
        const float* gp = gate + (size_t)((u.pm * 256) >> 12) * 6144;
        f32x4 gv[2][2];
#pragma unroll
        for (int bj = 0; bj < 2; ++bj) { gv[bj][0] = *(const f32x4*)(gp + col0 + bj * 128); gv[bj][1] = *(const f32x4*)(gp + col0 + bj * 128 + 4); }
#pragma unroll
        for (int ai = 0; ai < 2; ++ai)
#pragma unroll
            for (int m = 0; m < 4; ++m) {
                const int row = row0 + ai * 128 + m * 16;
                float sq = 0.f;
#pragma unroll
                for (int bj = 0; bj < 2; ++bj) {
                    const int col = col0 + bj * 128;
                    f32x4 x0, x1;
                    if (XBF) { const u32x4 xv = *(const u32x4*)((const bf16*)xin + (size_t)row * D + col); x0 = (f32x4){bflo(xv.x), bfhi(xv.x), bflo(xv.y), bfhi(xv.y)}; x1 = (f32x4){bflo(xv.z), bfhi(xv.z), bflo(xv.w), bfhi(xv.w)}; }
                    else { const float* xp = (const float*)xin + (size_t)row * D + col; x0 = *(const f32x4*)xp; x1 = *(const f32x4*)(xp + 4); }
                    const f32x4 y0 = x0 + gv[bj][0] * acc[ai][bj][m][0], y1 = x1 + gv[bj][1] * acc[ai][bj][m][1];
                    sq += (y0[0] * y0[0] + y0[1] * y0[1]) + (y0[2] * y0[2] + y0[3] * y0[3]) + (y1[0] * y1[0] + y1[1] * y1[1]) + (y1[2] * y1[2] + y1[3] * y1[3]);
                    u32x4 w; w.x = pk2(y0[0], y0[1]); w.y = pk2(y0[2], y0[3]); w.z = pk2(y1[0], y1[1]); w.w = pk2(y1[2], y1[3]);
                    *(u32x4*)(out + (size_t)row * D + col) = w;
                }
                sq += __shfl_xor(sq, 16); sq += __shfl_xor(sq, 32);
                if (fq == 0) ss2[(size_t)row * 32 + u.pn * 4 + wc] = sq;
            }
    }
};

constexpr int AT_TILE = 16384;
constexpr int AT_KB0 = 0, AT_VB0 = AT_TILE, AT_SLOT = 4 * AT_TILE, AT_FLAG = 2 * AT_SLOT;
constexpr float AT_DONE = 8.673617379884035e-19f;
DI int crow16(int i, int hh) { return (i & 3) + 8 * (i >> 2) + 4 * hh; }
DI int at_fx(int row) { return ((row & 3) << 2) | ((row >> 2) & 3); }
DI int at_off(int row, int ch) { return 256 * row + 16 * (ch ^ at_fx(row)); }
typedef short v4i16_t __attribute__((ext_vector_type(4)));

DI void attn_dma_tile(LAS unsigned char* lds, int rb, int w, int lane, size_t rowbase, int h, const bf16* Kb, const bf16* Vb) {
#pragma unroll
    for (int i = 0; i < 2; ++i) {
        const int piece = 2 * w + i, row = 4 * piece + (lane >> 4), ch = (lane & 15) ^ at_fx(row);
        const size_t goff = (rowbase + row) * D + h * 128 + ch * 8;
        __builtin_amdgcn_global_load_lds((const unsigned*)(Kb + goff), (LAS unsigned*)(lds + rb * 2 * AT_TILE + AT_KB0 + piece * 1024), 16, 0, 0);
        __builtin_amdgcn_global_load_lds((const unsigned*)(Vb + goff), (LAS unsigned*)(lds + rb * 2 * AT_TILE + AT_VB0 + piece * 1024), 16, 0, 0);
    }
}
struct AtRegs { f32x4 k[4], v[4]; };
DI void attn_move_sample(LAS unsigned char* lds, int buf, int tid, size_t rowbase, int h, const float* cK, const float* cV) {
    for (int c = tid - 64; c < 1024; c += 448) {
        const int key = c >> 4, ch = c & 15;
        const float* pk = cK + (rowbase + key) * D + h * 128 + ch * 8; const float* pv = cV + (rowbase + key) * D + h * 128 + ch * 8;
        const f32x4 a = *(const f32x4*)pk, b2 = *(const f32x4*)(pk + 4), c2 = *(const f32x4*)pv, d2 = *(const f32x4*)(pv + 4);
        u32x4 kv, vv;
        kv.x = pk2(a[0], a[1]); kv.y = pk2(a[2], a[3]); kv.z = pk2(b2[0], b2[1]); kv.w = pk2(b2[2], b2[3]);
        vv.x = pk2(c2[0], c2[1]); vv.y = pk2(c2[2], c2[3]); vv.z = pk2(d2[0], d2[1]); vv.w = pk2(d2[2], d2[3]);
        *(LAS u32x4*)(lds + buf * 2 * AT_TILE + AT_KB0 + at_off(key, ch)) = kv;
        *(LAS u32x4*)(lds + buf * 2 * AT_TILE + AT_VB0 + at_off(key, ch)) = vv;
    }
}
DI void attn_fetch_sample(AtRegs& r, int tid, bool newkeys, size_t rowbase, int h, const bf16* Kb, const bf16* Vb, const float* cK, const float* cV) {
#pragma unroll
    for (int i = 0; i < 2; ++i) {
        const int c = tid + 512 * i, key = c >> 4, ch = c & 15;
        if (newkeys) {
            u32x4 kv = {0u, 0u, 0u, 0u}, vv = {0u, 0u, 0u, 0u};
            if (key < DSEQ) { kv = *(const u32x4*)(Kb + (rowbase + key) * D + h * 128 + ch * 8); vv = *(const u32x4*)(Vb + (rowbase + key) * D + h * 128 + ch * 8); }
            r.k[2 * i] = __builtin_bit_cast(f32x4, kv); r.v[2 * i] = __builtin_bit_cast(f32x4, vv);
        } else {
            const float* pk = cK + (rowbase + key) * D + h * 128 + ch * 8; const float* pv = cV + (rowbase + key) * D + h * 128 + ch * 8;
            r.k[2 * i] = *(const f32x4*)pk; r.k[2 * i + 1] = *(const f32x4*)(pk + 4); r.v[2 * i] = *(const f32x4*)pv; r.v[2 * i + 1] = *(const f32x4*)(pv + 4);
        }
    }
}
DI void attn_commit_sample(const AtRegs& r, LAS unsigned char* lds, int buf, int tid, bool newkeys) {
#pragma unroll
    for (int i = 0; i < 2; ++i) {
        const int c = tid + 512 * i, key = c >> 4, ch = c & 15;
        u32x4 kv, vv;
        if (newkeys) { kv = __builtin_bit_cast(u32x4, r.k[2 * i]); vv = __builtin_bit_cast(u32x4, r.v[2 * i]); }
        else { const f32x4 a = r.k[2 * i], b2 = r.k[2 * i + 1], c2 = r.v[2 * i], d2 = r.v[2 * i + 1];
            kv.x = pk2(a[0], a[1]); kv.y = pk2(a[2], a[3]); kv.z = pk2(b2[0], b2[1]); kv.w = pk2(b2[2], b2[3]);
            vv.x = pk2(c2[0], c2[1]); vv.y = pk2(c2[2], c2[3]); vv.z = pk2(d2[0], d2[1]); vv.w = pk2(d2[2], d2[3]); }
        *(LAS u32x4*)(lds + buf * 2 * AT_TILE + AT_KB0 + at_off(key, ch)) = kv;
        *(LAS u32x4*)(lds + buf * 2 * AT_TILE + AT_VB0 + at_off(key, ch)) = vv;
    }
}

DI void attn_kv_out(int t, int nthr, int nchunks, size_t row0, int h, const bf16* Kb, const bf16* Vb, float* ok, float* ov) {
    for (int c = t; c < nchunks; c += nthr) {
        const size_t off = (row0 + (c >> 4)) * D + h * 128 + (c & 15) * 8;
        const u32x4 kv = *(const u32x4*)(Kb + off), vv = *(const u32x4*)(Vb + off);
        __builtin_nontemporal_store((f32x4){bflo(kv.x), bfhi(kv.x), bflo(kv.y), bfhi(kv.y)}, (f32x4*)(ok + off));
        __builtin_nontemporal_store((f32x4){bflo(kv.z), bfhi(kv.z), bflo(kv.w), bfhi(kv.w)}, (f32x4*)(ok + off + 4));
        __builtin_nontemporal_store((f32x4){bflo(vv.x), bfhi(vv.x), bflo(vv.y), bfhi(vv.y)}, (f32x4*)(ov + off));
        __builtin_nontemporal_store((f32x4){bflo(vv.z), bfhi(vv.z), bflo(vv.w), bfhi(vv.w)}, (f32x4*)(ov + off + 4));
    }
}
DI void attn_prologue(const Frame& F, bool sample, int b, int h, int qt, bf16x8 (&qf)[8], const bf16* Qb, const bf16* Kb, const bf16* Vb, const float* cK, const float* cV) {
    int tid = F.tid; asm volatile("" : "+v"(tid));
    const int w = F.wave, lane = tid & 63, r0 = lane & 31, hh0 = lane >> 5;
    size_t qrow; bool qvalid;
    if (!sample) { qrow = (size_t)b * SEQ + qt * 256 + 32 * w + r0; qvalid = true; }
    else { qrow = (size_t)MP + b * DSEQ + r0; qvalid = (w == 0) && (r0 < DSEQ); }
    if (!sample) {
#pragma unroll
        for (int T = 0; T < 3; ++T) attn_dma_tile(F.lds, T, w, lane, (size_t)b * SEQ + qt * 256 + 192 - 64 * T, h, Kb, Vb);
    }
#pragma unroll
    for (int s = 0; s < 8; ++s) { qf[s] = (bf16x8){0, 0, 0, 0, 0, 0, 0, 0}; if (qvalid) qf[s] = *(const bf16x8*)(Qb + qrow * D + h * 128 + 16 * s + 8 * hh0); }
    if (sample) { AtRegs SR; attn_fetch_sample(SR, tid, true, (size_t)MP + b * DSEQ, h, Kb, Vb, cK, cV); attn_commit_sample(SR, F.lds, 0, tid, true); }
}
DI void attn_epilogue(const Frame& F, bool sample, int b, int h, int qt, f32x16 (&o)[4], const bf16* ZG, bf16* OG) {
    int ln = F.lane; asm volatile("" : "+v"(ln));
    const int w = F.wave, r0 = ln & 31, hh0 = ln >> 5;
    size_t qrow; bool qvalid;
    if (!sample) { qrow = (size_t)b * SEQ + qt * 256 + 32 * w + r0; qvalid = true; }
    else { qrow = (size_t)MP + b * DSEQ + r0; qvalid = (w == 0) && (r0 < DSEQ); }
    if (qvalid) {
#pragma unroll
        for (int dt = 0; dt < 4; ++dt)
#pragma unroll
            for (int g = 0; g < 4; ++g) {
                const size_t off = qrow * D + h * 128 + 32 * dt + 8 * g + 4 * hh0;
                const u32x2 z = *(const u32x2*)(ZG + off);
                u32x2 ov; ov.x = pk2(o[dt][4 * g] * bflo(z.x), o[dt][4 * g + 1] * bfhi(z.x)); ov.y = pk2(o[dt][4 * g + 2] * bflo(z.y), o[dt][4 * g + 3] * bfhi(z.y));
                *(u32x2*)(OG + off) = ov;
            }
    }
#pragma unroll
    for (int dt = 0; dt < 4; ++dt)
#pragma unroll
        for (int i = 0; i < 16; ++i) o[dt][i] = 0.f;
}
DI void attn_unit(const Frame& F, bool sample, int b, int h, int qt, const bf16x8 (&qf)[8], f32x16 (&o)[4], bool stores_behind, const bf16* Kb, const bf16* Vb, const float* cK, const float* cV, float* okv, unsigned long long& at_probe_acc) {
    LAS unsigned char* lds = F.lds;
#ifdef PROBE_AT
    const unsigned long long at_t_unit = __builtin_amdgcn_s_memrealtime();
#endif
    (void)at_probe_acc;
    const int w = F.wave, slot = sample ? 0 : (w >> 2), wsl = w & 3, tlag = sample ? 0 : 2 * (1 - slot);
    const int lane0 = F.lane, r0 = lane0 & 31, hh0 = lane0 >> 5;
    int qpos, qmin, qmax; size_t qrow; bool qvalid;
    if (!sample) { qmin = qt * 256 + 32 * w; qpos = qmin + r0; qmax = qmin + 31; qrow = (size_t)b * SEQ + qpos; qvalid = true; }
    else { qmin = PAST; qmax = PAST + DSEQ - 1; qpos = PAST + r0; qrow = (size_t)MP + b * DSEQ + r0; qvalid = (w == 0) && (r0 < DSEQ); }
    const bool wave_active = sample ? (w == 0) : true;
    float R = 1.0f; bool done = !qvalid;
    const int ntiles = sample ? 1 + PAST / 64 : 4 * (qt + 1);
    const int kb0 = qt * 256 + 192 - 64 * tlag;
    volatile LAS unsigned* flags = (volatile LAS unsigned*)(lds + AT_FLAG);
#ifdef PROBE_AT
    if (PROBE_AT == 2) at_probe_acc += __builtin_amdgcn_s_memrealtime() - at_t_unit;
#endif
    for (int ti = 0; ti < ntiles; ++ti) {
#ifdef PROBE_AT
        const unsigned long long ta0 = __builtin_amdgcn_s_memrealtime();
#endif
        if ((!sample && (ti == 1 || ti == 2)) || (ti == 0 && stores_behind)) asm volatile("s_waitcnt vmcnt(16) lgkmcnt(0)" ::: "memory"); else asm volatile("s_waitcnt vmcnt(0) lgkmcnt(0)" ::: "memory");
        __builtin_amdgcn_s_barrier(); asm volatile("" ::: "memory");
#ifdef PROBE_AT
        const unsigned long long ta1 = __builtin_amdgcn_s_memrealtime();
        if (PROBE_AT == 1 || PROBE_AT == 4) at_probe_acc += ta1 - ta0;
#endif
        if (ti > 0) {
            unsigned alld = 1u;
#pragma unroll
            for (int i = 0; i < 8; ++i) alld &= flags[((ti - 1) & 1) * 8 + i];
            if (alld) break;
        }
        int tid = F.tid; asm volatile("" : "+v"(tid));
        const int lane = tid & 63, r = lane & 31, hh = lane >> 5;
        const int buf = sample ? (ti & 1) : ((ti + tlag) & 3), nbuf = (ti & 1) ^ 1;
        const int kbase = sample ? (ti == 0 ? PAST : PAST - 64 * ti) : kb0 - 64 * ti;
        const bool more = ti + 1 < ntiles;
        if (more) {
            if (!sample) { const int kb3 = qt * 256 + 192 - 64 * (ti + 3); if (kb3 >= 0) attn_dma_tile(lds, (ti + 3) & 3, w, lane, (size_t)b * SEQ + kb3, h, Kb, Vb); }
            else if (w != 0) attn_move_sample(lds, nbuf, tid, (size_t)b * PAST + (PAST - 64 * (ti + 1)), h, cK, cV);
        }
        if (!sample) {
            if (ti < 2) {
                const LAS unsigned char* kt_ = lds + buf * 2 * AT_TILE + AT_KB0; const LAS unsigned char* vt_ = lds + buf * 2 * AT_TILE + AT_VB0;
                const int ts = wsl * 64 + lane;
#pragma unroll
                for (int i = 0; i < 4; ++i) {
                    const int c = ts + 256 * i, row = c >> 4, ch = c & 15, lo = at_off(row, ch);
                    const u32x4 kv = *(const LAS u32x4*)(kt_ + lo), vv = *(const LAS u32x4*)(vt_ + lo);
                    const size_t goff = ((size_t)b * SEQ + kbase + row) * D + h * 128 + ch * 8;
                    __builtin_nontemporal_store((f32x4){bflo(kv.x), bfhi(kv.x), bflo(kv.y), bfhi(kv.y)}, (f32x4*)(okv + OKP + goff));
                    __builtin_nontemporal_store((f32x4){bflo(kv.z), bfhi(kv.z), bflo(kv.w), bfhi(kv.w)}, (f32x4*)(okv + OKP + goff + 4));
                    __builtin_nontemporal_store((f32x4){bflo(vv.x), bfhi(vv.x), bflo(vv.y), bfhi(vv.y)}, (f32x4*)(okv + OVP + goff));
                    __builtin_nontemporal_store((f32x4){bflo(vv.z), bfhi(vv.z), bflo(vv.w), bfhi(vv.w)}, (f32x4*)(okv + OVP + goff + 4));
                }
            }
        }
        else if (ti == 0 && w != 0) attn_kv_out(tid - 64, 448, 256, (size_t)MP + b * DSEQ, h, Kb, Vb, okv + OKS - (size_t)MP * D, okv + OVS - (size_t)MP * D);
        if (kbase < 0) done = true;
        bool wdone = __all(done);
        if (wave_active && !wdone && kbase >= 0 && kbase < qmax) {
            const LAS unsigned char* kt = lds + buf * 2 * AT_TILE + AT_KB0;
            const LAS unsigned char* vt = lds + buf * 2 * AT_TILE + AT_VB0;
#pragma unroll
            for (int kbi = 0; kbi < 2; ++kbi) {
                const int kb = 1 - kbi, kb_base = kbase + 32 * kb;
                if (kb_base >= qmax) continue;
                const bool needmask = (kb_base + 31 >= qmin);
                f32x16 acc;
#pragma unroll
                for (int i = 0; i < 16; ++i) acc[i] = 0.f;
                {
                    const int krow = 32 * kb + r, fx = at_fx(krow);
#pragma unroll
                    for (int s = 0; s < 8; ++s) {
                        const bf16x8 a = *(const LAS bf16x8*)(kt + 256 * krow + 16 * ((2 * s + hh) ^ fx));
                        acc = __builtin_amdgcn_mfma_f32_32x32x16_bf16(a, qf[s], acc, 0, 0, 0);
                    }
                }
                float keep[16], av[16];
#pragma unroll
                for (int i = 0; i < 16; ++i) {
                    const float z = acc[i];
                    const float u = __builtin_amdgcn_exp2f(-__builtin_fabsf(z));
                    const float rr = __builtin_amdgcn_rcpf(1.0f + u);
                    const bool pos = z >= 0.f;
                    float kp = (pos ? u : 1.0f) * rr, bt = (pos ? 1.0f : u) * rr;
                    if (needmask) { const int kpos = kb_base + crow16(i, hh); const bool ok = kpos < qpos; kp = ok ? kp : 1.0f; bt = ok ? bt : 0.f; }
                    keep[i] = kp; av[i] = bt;
                }
                float GL[4], GH[4];
#pragma unroll
                for (int g = 0; g < 4; ++g) { const float gs = (keep[4 * g] * keep[4 * g + 1]) * (keep[4 * g + 2] * keep[4 * g + 3]);
                    auto sw = __builtin_amdgcn_permlane32_swap(__float_as_uint(gs), __float_as_uint(gs), false, false); GL[g] = __uint_as_float(sw[0]); GH[g] = __uint_as_float(sw[1]); }
                float off = R;
#pragma unroll
                for (int g = 3; g >= 0; --g) {
                    const float p3 = hh ? off : off * GH[g];
                    off *= GL[g] * GH[g];
                    const float p2 = p3 * keep[4 * g + 3], p1 = p2 * keep[4 * g + 2], p0_ = p1 * keep[4 * g + 1];
                    av[4 * g + 3] *= p3; av[4 * g + 2] *= p2; av[4 * g + 1] *= p1; av[4 * g] *= p0_;
                }
                R = off;
                u32x4 p0, p1;
                p0.x = pk2(av[0], av[1]); p0.y = pk2(av[2], av[3]); p0.z = pk2(av[4], av[5]); p0.w = pk2(av[6], av[7]);
                p1.x = pk2(av[8], av[9]); p1.y = pk2(av[10], av[11]); p1.z = pk2(av[12], av[13]); p1.w = pk2(av[14], av[15]);
                const bf16x8 pf0 = __builtin_bit_cast(bf16x8, p0), pf1 = __builtin_bit_cast(bf16x8, p1);
                {
                    const int blk = (lane >> 4) & 1, q = (lane & 15) >> 2, p = lane & 3;
                    const unsigned vt0 = (unsigned)(size_t)vt + 8192u * kb + 256u * (4 * hh + q) + 8u * (p & 1);
                    unsigned vb[4][2];
#pragma unroll
                    for (int dt = 0; dt < 4; ++dt)
#pragma unroll
                        for (int tp = 0; tp < 2; ++tp) vb[dt][tp] = vt0 + 2048u * tp + 64u * (dt ^ q) + 16u * ((2 * blk + (p >> 1)) ^ (2 * tp + hh));
                    s16x4 vr[4][4];
                    asm volatile(
                        "ds_read_b64_tr_b16 %0, %16\n\tds_read_b64_tr_b16 %1, %17\n\tds_read_b64_tr_b16 %2, %16 offset:4096\n\tds_read_b64_tr_b16 %3, %17 offset:4096\n\t"
                        "ds_read_b64_tr_b16 %4, %18\n\tds_read_b64_tr_b16 %5, %19\n\tds_read_b64_tr_b16 %6, %18 offset:4096\n\tds_read_b64_tr_b16 %7, %19 offset:4096\n\t"
                        "ds_read_b64_tr_b16 %8, %20\n\tds_read_b64_tr_b16 %9, %21\n\tds_read_b64_tr_b16 %10, %20 offset:4096\n\tds_read_b64_tr_b16 %11, %21 offset:4096\n\t"
                        "ds_read_b64_tr_b16 %12, %22\n\tds_read_b64_tr_b16 %13, %23\n\tds_read_b64_tr_b16 %14, %22 offset:4096\n\tds_read_b64_tr_b16 %15, %23 offset:4096\n\t"
                        "s_waitcnt lgkmcnt(0)"
                        : "=&v"(vr[0][0]), "=&v"(vr[0][1]), "=&v"(vr[0][2]), "=&v"(vr[0][3]), "=&v"(vr[1][0]), "=&v"(vr[1][1]), "=&v"(vr[1][2]), "=&v"(vr[1][3]),
                          "=&v"(vr[2][0]), "=&v"(vr[2][1]), "=&v"(vr[2][2]), "=&v"(vr[2][3]), "=&v"(vr[3][0]), "=&v"(vr[3][1]), "=&v"(vr[3][2]), "=&v"(vr[3][3])
                        : "v"(vb[0][0]), "v"(vb[0][1]), "v"(vb[1][0]), "v"(vb[1][1]), "v"(vb[2][0]), "v"(vb[2][1]), "v"(vb[3][0]), "v"(vb[3][1])
                        : "memory");
#pragma unroll
                    for (int dt = 0; dt < 4; ++dt) {
                        const bf16x8 va0 = __builtin_shufflevector(vr[dt][0], vr[dt][1], 0, 1, 2, 3, 4, 5, 6, 7), va1 = __builtin_shufflevector(vr[dt][2], vr[dt][3], 0, 1, 2, 3, 4, 5, 6, 7);
                        o[dt] = __builtin_amdgcn_mfma_f32_32x32x16_bf16(va0, pf0, o[dt], 0, 0, 0);
                        o[dt] = __builtin_amdgcn_mfma_f32_32x32x16_bf16(va1, pf1, o[dt], 0, 0, 0);
                    }
                }
            }
            done = done || (R < AT_DONE);
            wdone = __all(done);
        }
        if (lane == 0) flags[(ti & 1) * 8 + w] = (wdone || !wave_active) ? 1u : 0u;
#ifdef PROBE_AT
        if (PROBE_AT == 3) at_probe_acc += __builtin_amdgcn_s_memrealtime() - ta1;
#endif
    }
}
constexpr int CW_ATQ = 8192;
struct AtU { bool valid, sample; int b, h, qt; };
DI AtU at_decode(int u) {
    AtU U; U.valid = u < 2048 + 128; U.sample = u < 128;
    if (!U.sample) { u -= 128; const int c = u & 255, rnd = u >> 8; U.qt = (rnd & 1) == 0 ? (c & 15) : 15 - (c & 15); const int bh = (c >> 4) + 16 * rnd; U.b = bh >> 4; U.h = bh & 15; }
    else { const int bh = u; U.qt = 0; U.b = (bh >> 4) & 7; U.h = bh & 15; }
    return U;
}
DI void phase_attn(const Frame& F, CParams& P, const bf16* Qb, const bf16* Kb, const bf16* Vb, const bf16* ZG, bf16* OG) {
    const float* cK = P.in[2]; const float* cV = P.in[3];
    unsigned long long at_probe_acc = 0ull;
    unsigned* qhead = (unsigned*)(P.ws + WS_CTL) + CW_ATQ;
    volatile LAS unsigned* nextu = (volatile LAS unsigned*)(F.lds + AT_FLAG + 64);
    if (F.tid == 0) nextu[0] = __hip_atomic_fetch_add(qhead, 1u, __ATOMIC_RELAXED, __HIP_MEMORY_SCOPE_AGENT);
    LDS_BARRIER();
    AtU U = at_decode((int)nextu[0]);
    LDS_BARRIER();
    if (!U.valid) return;
    bf16x8 qf[8]; f32x16 o[4];
#pragma unroll
    for (int dt = 0; dt < 4; ++dt)
#pragma unroll
        for (int i = 0; i < 16; ++i) o[dt][i] = 0.f;
    attn_prologue(F, U.sample, U.b, U.h, U.qt, qf, Qb, Kb, Vb, cK, cV);
    bool stores_behind = false;
    for (;;) {
        if (F.tid == 0) nextu[0] = __hip_atomic_fetch_add(qhead, 1u, __ATOMIC_RELAXED, __HIP_MEMORY_SCOPE_AGENT);
        attn_unit(F, U.sample, U.b, U.h, U.qt, qf, o, stores_behind, Kb, Vb, cK, cV, P.out, at_probe_acc);
        LDS_BARRIER();
        const AtU UN = at_decode((int)nextu[0]);
        if (UN.valid) attn_prologue(F, UN.sample, UN.b, UN.h, UN.qt, qf, Qb, Kb, Vb, cK, cV);
        attn_epilogue(F, U.sample, U.b, U.h, U.qt, o, ZG, OG);
        stores_behind = U.sample ? (F.wave == 0) : true;
        LDS_BARRIER();
        if (!UN.valid) break;
        U = UN;
    }
}

constexpr int G1_P = 544;
constexpr int G1_QI = 0, G1_KD = 64 * G1_P, G1_ALR = 2 * 64 * G1_P, G1_TOT = G1_ALR + 4096, G1_AM = G1_TOT + 2048;
struct G1Regs { u32x4 q[4], k[4]; f32x4 a; float wa2[16]; float ba; };
struct G1Unit { bool sample; int b, c, h; size_t row0, uh; int nvalid; };
DI G1Unit g1_decode(int u) {
    G1Unit U;
    if (u < 2048) { U.sample = false; U.b = u >> 8; U.c = (u >> 2) & 63; U.h = u & 3; U.row0 = (size_t)U.b * SEQ + U.c * 64; U.nvalid = 64; U.uh = (size_t)(U.b * 4 + U.h) * 64 + U.c; }
    else { U.sample = true; U.b = (u - 2048) >> 2; U.c = 0; U.h = (u - 2048) & 3; U.row0 = (size_t)MP + U.b * DSEQ; U.nvalid = DSEQ; U.uh = 2048 + U.b * 4 + U.h; }
    return U;
}
DI void g1_fetch(G1Regs& r, const G1Unit& U, int tid, const bf16* QK, const float* ALR, const float* wa2p, const float* bap) {
#pragma unroll
    for (int i = 0; i < 4; ++i) { const int cidx = tid + 512 * i, t = cidx >> 5, ch = cidx & 31;
        r.q[i] = (u32x4){0u, 0u, 0u, 0u}; r.k[i] = (u32x4){0u, 0u, 0u, 0u};
        if (t < U.nvalid) { r.q[i] = *(const u32x4*)(QK + (U.row0 + t) * D + U.h * 256 + ch * 8); r.k[i] = *(const u32x4*)(QK + (U.row0 + t) * D + 1024 + U.h * 256 + ch * 8); } }
    { const int t = (tid & 255) >> 2; r.a = (f32x4){0.f, 0.f, 0.f, 0.f}; if (t < U.nvalid) r.a = *(const f32x4*)(ALR + (U.row0 + t) * 16 + (tid & 3) * 4); }
    const int col = U.h * 256 + (tid & 255);
#pragma unroll
    for (int rr = 0; rr < 16; ++rr) r.wa2[rr] = wa2p[rr * 1024 + col];
    r.ba = bap[col];
}
DI void gla_prep_unit(const Frame& F, CParams& P, const G1Unit& U, G1Regs& R, bool has_next, const G1Unit& UN, bf16* QK) {
    LAS unsigned char* lds = F.lds;
    unsigned char* ws = P.ws;
    int tid = F.tid; asm volatile("" : "+v"(tid));
    const int lane = tid & 63, w = F.wave, i16 = lane & 15, g4 = lane >> 4;
    const size_t row0 = U.row0, uh = U.uh; const int nvalid = U.nvalid, h = U.h;
    bf16* KLT = (bf16*)(ws + WS_KLT); bf16* AM = (bf16*)(ws + WS_AM); float* EB = (float*)(ws + WS_EB);
    const float* ALR = (const float*)(ws + WS_ALR);
#pragma unroll
    for (int i = 0; i < 4; ++i) { const int cidx = tid + 512 * i, t = cidx >> 5, ch = cidx & 31;
        *(LAS u32x4*)(lds + G1_QI + t * G1_P + ch * 16) = R.q[i]; *(LAS u32x4*)(lds + G1_KD + t * G1_P + ch * 16) = R.k[i]; }
    *(LAS f32x4*)(lds + G1_ALR + (tid & 255) * 16) = R.a;
    const int dk = tid & 255, half = tid >> 8;
    f32x2 wa2[8];
#pragma unroll
    for (int rr = 0; rr < 8; ++rr) wa2[rr] = (f32x2){R.wa2[2 * rr] * 1.4426950408889634f, R.wa2[2 * rr + 1] * 1.4426950408889634f};
    const float ba = R.ba * 1.4426950408889634f;
    LDS_BARRIER();
    if (has_next) g1_fetch(R, UN, tid, QK, ALR, P.in[13], P.in[14]);
    const LAS float* alr = (const LAS float*)(lds + G1_ALR);
    LAS float* tot = (LAS float*)(lds + G1_TOT);
    float gl[32]; float pre = 0.f;
#pragma unroll
    for (int tt = 0; tt < 32; ++tt) {
        const int t = 32 * half + tt;
        f32x2 xa = {ba, 0.f};
#pragma unroll
        for (int j = 0; j < 4; ++j) { const f32x4 av = *(const LAS f32x4*)(alr + t * 16 + 4 * j); xa += (f32x2){av[0], av[1]} * wa2[2 * j]; xa += (f32x2){av[2], av[3]} * wa2[2 * j + 1]; }
        const float x = xa[0] + xa[1];
        const float lsig2 = __builtin_fminf(x, 0.f) - __builtin_amdgcn_logf(1.0f + __builtin_amdgcn_exp2f(-__builtin_fabsf(x)));
        const float gt = (t < nvalid) ? lsig2 * 0.0625f : 0.f;
        pre += gt; gl[tt] = pre;
    }
    tot[half * 256 + dk] = pre;
    LDS_BARRIER();
    const float t0 = tot[dk], t1 = tot[256 + dk];
    const float boff = half ? t0 : 0.f, blast = t0 + t1;
    unsigned klw[16];
#pragma unroll
    for (int tt = 0; tt < 32; tt += 2) {
        float klv[2];
#pragma unroll
        for (int q2 = 0; q2 < 2; ++q2) {
            const int t = 32 * half + tt + q2;
            const float bt = boff + gl[tt + q2];
            LAS unsigned short* qp = (LAS unsigned short*)(lds + G1_QI + t * G1_P + dk * 2);
            LAS unsigned short* kp = (LAS unsigned short*)(lds + G1_KD + t * G1_P + dk * 2);
            const float qv = bf2f(*qp), kv = bf2f(*kp);
            const float qi = qv * 0.0625f * __builtin_amdgcn_exp2f(bt), kd = kv * __builtin_amdgcn_exp2f(-bt);
            klv[q2] = kv * __builtin_amdgcn_exp2f(blast - bt);
            *qp = (unsigned short)(pk2(qi, 0.f) & 0xffffu);
            *kp = (unsigned short)(pk2(kd, 0.f) & 0xffffu);
        }
        klw[tt >> 1] = pk2(klv[0], klv[1]);
    }
    {
        u32x4* dst = (u32x4*)(KLT + (uh * 256 + dk) * 64 + 32 * half);
#pragma unroll
        for (int j = 0; j < 4; ++j) dst[j] = (u32x4){klw[4 * j], klw[4 * j + 1], klw[4 * j + 2], klw[4 * j + 3]};
    }
    if (half == 1) EB[uh * 256 + dk] = __builtin_amdgcn_exp2f(blast);
    LDS_BARRIER();
    {
        const int ct = w >> 1;
#pragma unroll
        for (int sti = 0; sti < 2; ++sti) {
            const int st = 2 * (w & 1) + sti;
            f32x4 accA = {0.f, 0.f, 0.f, 0.f};
#pragma unroll
            for (int ks = 0; ks < 8; ++ks) {
                const bf16x8 a = *(const LAS bf16x8*)(lds + G1_QI + (16 * ct + i16) * G1_P + (32 * ks + 8 * g4) * 2);
                const bf16x8 bb = *(const LAS bf16x8*)(lds + G1_KD + (16 * st + i16) * G1_P + (32 * ks + 8 * g4) * 2);
                accA = __builtin_amdgcn_mfma_f32_16x16x32_bf16(a, bb, accA, 0, 0, 0);
            }
#pragma unroll
            for (int e = 0; e < 4; ++e) { const int cc = 16 * ct + 4 * g4 + e, ss = 16 * st + i16; const float v = cc >= ss ? accA[e] : 0.f;
                *(LAS unsigned short*)(lds + G1_AM + cc * 128 + ss * 2) = (unsigned short)(pk2(v, 0.f) & 0xffffu); }
        }
    }
#pragma unroll
    for (int i = 0; i < 4; ++i) { const int cidx = tid + 512 * i, t = cidx >> 5, ch = cidx & 31;
        if (t < nvalid) *(u32x4*)(QK + (row0 + t) * D + h * 256 + ch * 8) = *(const LAS u32x4*)(lds + G1_QI + t * G1_P + ch * 16); }
    LDS_BARRIER();
    *(u32x4*)(AM + uh * 4096 + tid * 8) = *(const LAS u32x4*)(lds + G1_AM + tid * 16);
}
DI void phase_gla_prep(const Frame& F, CParams& P, bf16* QK) {
    int u = (int)blockIdx.x;
    if (u >= 2080) return;
    G1Regs R; G1Unit U = g1_decode(u);
    g1_fetch(R, U, F.tid, QK, (const float*)(P.ws + WS_ALR), P.in[13], P.in[14]);
    for (;;) {
        const int un = u + F.G; const bool has_next = un < 2080;
        const G1Unit UN = g1_decode(has_next ? un : u);
        gla_prep_unit(F, P, U, R, has_next, UN, QK);
        if (!has_next) break;
        u = un; U = UN;
    }
}

constexpr int G2_QP = 544, G2_TP = 160;
constexpr int G2_QI = 0, G2_VT = 64 * G2_QP, G2_AM = G2_VT + 64 * G2_TP, G2_EB = G2_AM + 64 * G2_TP;
struct G2Regs { u32x4 q[4], v, a; };
DI void g2_fetch(G2Regs& r, int tid, int nvalid, const bf16* qb, const bf16* vbp, const bf16* ab) {
#pragma unroll
    for (int i = 0; i < 4; ++i) {
        const unsigned cidx = tid + 512 * i;
        { const unsigned t = cidx >> 5, ch = cidx & 31; r.q[i] = (u32x4){0u, 0u, 0u, 0u}; if ((int)t < nvalid) r.q[i] = *(const u32x4*)(qb + (t * (unsigned)D + ch * 8u)); }
    }
    { const unsigned t = tid & 63, dch = tid >> 6; r.v = (u32x4){0u, 0u, 0u, 0u}; if ((int)t < nvalid) r.v = *(const u32x4*)(vbp + (t * (unsigned)D + dch * 8u)); }
    r.a = *(const u32x4*)(ab + (unsigned)tid * 8u);
}
DI void g2_fetch_kl(bf16x8 (&kl)[4][2], f32x4 (&eb)[4], const bf16* klt, const float* ebp, int w, int i16, int g4) {
#pragma unroll
    for (int jt = 0; jt < 4; ++jt) {
        const bf16* p = klt + (unsigned)((64 * w + 16 * jt + i16) * 64 + 8 * g4);
        kl[jt][0] = *(const bf16x8*)p; kl[jt][1] = *(const bf16x8*)(p + 32);
        eb[jt] = *(const f32x4*)(ebp + 64 * w + 16 * jt + 4 * g4);
    }
}
DI void g2_stage(const G2Regs& r, LAS unsigned char* lds, int tid) {
#pragma unroll
    for (int i = 0; i < 4; ++i) {
        const int cidx = tid + 512 * i;
        { const int t = cidx >> 5, ch = cidx & 31; *(LAS u32x4*)(lds + G2_QI + t * G2_QP + ch * 16) = r.q[i]; }
    }
    { const int t = tid & 63, dch = tid >> 6; const u32x4 v = r.v;
      LAS unsigned short* vt = (LAS unsigned short*)(lds + G2_VT + (dch * 8) * G2_TP + t * 2);
      vt[0 * (G2_TP / 2)] = (unsigned short)(v.x & 0xffffu); vt[1 * (G2_TP / 2)] = (unsigned short)(v.x >> 16);
      vt[2 * (G2_TP / 2)] = (unsigned short)(v.y & 0xffffu); vt[3 * (G2_TP / 2)] = (unsigned short)(v.y >> 16);
      vt[4 * (G2_TP / 2)] = (unsigned short)(v.z & 0xffffu); vt[5 * (G2_TP / 2)] = (unsigned short)(v.z >> 16);
      vt[6 * (G2_TP / 2)] = (unsigned short)(v.w & 0xffffu); vt[7 * (G2_TP / 2)] = (unsigned short)(v.w >> 16); }
    { const int cc = tid >> 3, ch = tid & 7; *(LAS u32x4*)(lds + G2_AM + cc * G2_TP + ch * 16) = r.a; }
}
constexpr int G2_SP = G2_EB + 1024, G2_SPP = 528, G2_SPB = 16 * G2_SPP;
static_assert(G2_SP + 8 * G2_SPB <= LDS_MISC, "G2 LDS map");
DI void g2_flush_o(LAS unsigned char* lds, int buf, int tid, int nvalid, bf16* obase, float* sbq) {
    const int cc = tid >> 3, dq = (tid >> 1) & 3, half = tid & 1;
    const u32x4 v = *(const LAS u32x4*)(lds + G2_SP + (buf * 4 + dq) * G2_SPB + cc * 32 + half * 16);
    float ss = (bflo(v.x) * bflo(v.x) + bfhi(v.x) * bfhi(v.x)) + (bflo(v.y) * bflo(v.y) + bfhi(v.y) * bfhi(v.y)) + (bflo(v.z) * bflo(v.z) + bfhi(v.z) * bfhi(v.z)) + (bflo(v.w) * bflo(v.w) + bfhi(v.w) * bfhi(v.w));
    ss += dppf<0xB1>(ss); ss += dppf<0x4E>(ss); ss += dppf<0x141>(ss);
    if (cc < nvalid) {
        *(u32x4*)(obase + (unsigned)(cc * D + 16 * dq + 8 * half)) = v;
        if ((tid & 7) == 0) sbq[(unsigned)(cc * 32)] = ss;
    }
}
DI void gla_scan_unit(const Frame& F, CParams& P, bool sample, int b, int h, int sl, const bf16* QK, const bf16* V1, bf16* Ob, unsigned long long& g2_probe_acc) {
    (void)g2_probe_acc;
    LAS unsigned char* lds = F.lds;
    unsigned char* ws = P.ws;
    const int w = F.wave, swave = w < 4, dq = w & 3;
    const bf16* KLT = (const bf16*)(ws + WS_KLT); const bf16* AM = (const bf16*)(ws + WS_AM); const float* EB = (const float*)(ws + WS_EB);
    float* SSQ = (float*)(ws + WS_SSQ);
    f32x4 S[16];
    const int lane0 = F.lane, i16_0 = lane0 & 15, g4_0 = lane0 >> 4;
    const size_t sbase = ((size_t)(b * 4 + h) * 256 + 64 * (w & 3) + 4 * g4_0) * 512 + sl * 64 + i16_0;
#pragma unroll
    for (int j = 0; j < 16; ++j) S[j] = (f32x4){0.f, 0.f, 0.f, 0.f};
    if (sample && swave) {
        const float* st = P.in[4] + sbase;
#pragma unroll
        for (int j = 0; j < 16; ++j) {
            const float* pj = st + (size_t)(16 * (j >> 2)) * 512 + 16 * (j & 3); asm volatile("" : "+v"(pj));
#pragma unroll
            for (int e = 0; e < 4; ++e) S[j][e] = pj[e * 512];
        }
    }
    if (swave) {
        LAS unsigned char* sp = lds + G2_SP + 4 * G2_SPB + i16_0 * G2_SPP + (64 * w + 4 * g4_0) * 2;
#pragma unroll
        for (int j = 0; j < 16; ++j) *(LAS u32x2*)(sp + (j & 3) * G2_SPB + 32 * (j >> 2)) = (u32x2){pk2(S[j][0], S[j][1]), pk2(S[j][2], S[j][3])};
    }
    const int nchunks = sample ? 1 : 64, nvalid = sample ? DSEQ : 64;
    const size_t rowb = sample ? (size_t)MP + b * DSEQ : (size_t)b * SEQ;
    const size_t uhb = sample ? 2048 + b * 4 + h : (size_t)(b * 4 + h) * 64;
    G2Regs R;
    { int t0 = F.tid; asm volatile("" : "+v"(t0)); g2_fetch(R, t0, nvalid, QK + rowb * D + h * 256, V1 + rowb * D + h * 512 + sl * 64, AM + uhb * 4096); }
    bf16x8 klN[4][2]; f32x4 ebN[4];
    if (swave) { int ln0 = F.lane; asm volatile("" : "+v"(ln0)); g2_fetch_kl(klN, ebN, KLT + uhb * 16384, EB + uhb * 256, w, ln0 & 15, ln0 >> 4); }
    for (int c = 0; c < nchunks; ++c) {
        const size_t row0 = rowb + (size_t)c * 64;
        int tid = F.tid; asm volatile("" : "+v"(tid));
        const int lane = tid & 63, i16 = lane & 15, g4 = lane >> 4;
        g2_stage(R, lds, tid);
        if (c > 0) g2_flush_o(lds, c & 1, tid, nvalid, Ob + (row0 - 64) * D + h * 512 + sl * 64, SSQ + (row0 - 64) * 32 + h * 8 + sl);
        LDS_BARRIER();
        if (c + 1 < nchunks) g2_fetch(R, tid, nvalid, QK + (row0 + 64) * D + h * 256, V1 + (row0 + 64) * D + h * 512 + sl * 64, AM + (uhb + c + 1) * 4096);
        if (swave) {
            __builtin_amdgcn_s_setprio(2);
            bf16x8 vall[4][2];
#pragma unroll
            for (int q = 0; q < 4; ++q)
#pragma unroll
                for (int ks = 0; ks < 2; ++ks) vall[q][ks] = *(const LAS bf16x8*)(lds + G2_VT + (16 * q + i16) * G2_TP + (32 * ks + 8 * g4) * 2);
            LAS unsigned char* sp = lds + G2_SP + ((c & 1) * 4) * G2_SPB + i16 * G2_SPP + (64 * w + 4 * g4) * 2;
#pragma unroll
            for (int jt = 0; jt < 4; ++jt)
#pragma unroll
                for (int q = 0; q < 4; ++q) { const int j = 4 * jt + q; S[j] = S[j] * ebN[jt];
                    S[j] = __builtin_amdgcn_mfma_f32_16x16x32_bf16(klN[jt][0], vall[q][0], S[j], 0, 0, 0); S[j] = __builtin_amdgcn_mfma_f32_16x16x32_bf16(klN[jt][1], vall[q][1], S[j], 0, 0, 0); }
            if (c + 1 < nchunks) g2_fetch_kl(klN, ebN, KLT + (uhb + c + 1) * 16384, EB + (uhb + c + 1) * 256, w, i16, g4);
#pragma unroll
            for (int j = 0; j < 16; ++j) *(LAS u32x2*)(sp + (j & 3) * G2_SPB + 32 * (j >> 2)) = (u32x2){pk2(S[j][0], S[j][1]), pk2(S[j][2], S[j][3])};
            __builtin_amdgcn_s_setprio(0);
        } else {
            bf16x8 vb[2];
#pragma unroll
            for (int ks = 0; ks < 2; ++ks) vb[ks] = *(const LAS bf16x8*)(lds + G2_VT + (16 * dq + i16) * G2_TP + (32 * ks + 8 * g4) * 2);
            LAS unsigned char* slice = lds + G2_SP + (((c + 1) & 1) * 4 + dq) * G2_SPB;
            bf16x8 bS[8];
#pragma unroll
            for (int ks = 0; ks < 8; ++ks) bS[ks] = *(const LAS bf16x8*)(slice + i16 * G2_SPP + (8 * g4) * 2 + 64 * ks);
            const LAS unsigned char* amp = lds + G2_AM + i16 * G2_TP + (8 * g4) * 2;
            const LAS unsigned char* qip = lds + G2_QI + i16 * G2_QP + (8 * g4) * 2;
            f32x4 O[4];
            bf16x8 amA[2], qaA[8], amB[2], qaB[8];
#define G2_LDF(am_, qa_, ct_) do { am_[0] = *(const LAS bf16x8*)(amp + (16 * (ct_)) * G2_TP); am_[1] = *(const LAS bf16x8*)(amp + (16 * (ct_)) * G2_TP + 64); \
            _Pragma("unroll") for (int ks = 0; ks < 8; ++ks) qa_[ks] = *(const LAS bf16x8*)(qip + (16 * (ct_)) * G2_QP + 64 * ks); } while (0)
#define G2_MMO(am_, qa_, ct_) do { f32x4 oa_ = __builtin_amdgcn_mfma_f32_16x16x32_bf16(am_[0], vb[0], (f32x4){0.f, 0.f, 0.f, 0.f}, 0, 0, 0), ob_ = __builtin_amdgcn_mfma_f32_16x16x32_bf16(am_[1], vb[1], (f32x4){0.f, 0.f, 0.f, 0.f}, 0, 0, 0); \
            _Pragma("unroll") for (int ks = 0; ks < 8; ks += 2) { oa_ = __builtin_amdgcn_mfma_f32_16x16x32_bf16(qa_[ks], bS[ks], oa_, 0, 0, 0); ob_ = __builtin_amdgcn_mfma_f32_16x16x32_bf16(qa_[ks + 1], bS[ks + 1], ob_, 0, 0, 0); } \
            O[ct_] = oa_ + ob_; } while (0)
            G2_LDF(amA, qaA, 0);
            __builtin_amdgcn_sched_barrier(0);
            G2_LDF(amB, qaB, 1); G2_MMO(amA, qaA, 0);
            __builtin_amdgcn_sched_barrier(0);
            G2_LDF(amA, qaA, 2); G2_MMO(amB, qaB, 1);
            __builtin_amdgcn_sched_barrier(0);
            G2_LDF(amB, qaB, 3); G2_MMO(amA, qaA, 2);
            __builtin_amdgcn_sched_barrier(0);
            G2_MMO(amB, qaB, 3);
#undef G2_LDF
#undef G2_MMO
#pragma unroll
            for (int ct = 0; ct < 4; ++ct)
#pragma unroll
                for (int e = 0; e < 4; ++e) *(LAS unsigned short*)(slice + (16 * ct + 4 * g4 + e) * 32 + i16 * 2) = (unsigned short)(pk2(O[ct][e], 0.f) & 0xffffu);
        }
        LDS_BARRIER();
    }
    {
        int tid = F.tid; asm volatile("" : "+v"(tid));
        const size_t rowl = rowb + (size_t)(nchunks - 1) * 64;
        g2_flush_o(lds, nchunks & 1, tid, nvalid, Ob + rowl * D + h * 512 + sl * 64, SSQ + rowl * 32 + h * 8 + sl);
    }
    if (swave) {
        float* so = P.out + (sample ? OSS : OSP) + sbase;
#pragma unroll
        for (int j = 0; j < 16; ++j) {
            float* pj = so + (size_t)(16 * (j >> 2)) * 512 + 16 * (j & 3); asm volatile("" : "+v"(pj));
#pragma unroll
            for (int e = 0; e < 4; ++e) pj[e * 512] = S[j][e];
        }
    }
    LDS_BARRIER();
}
DI void phase_gla_scan(const Frame& F, CParams& P, const bf16* QK, const bf16* V1, bf16* Ob) {
    unsigned long long g2_probe_acc = 0ull;
    for (int u = blockIdx.x; u < 512; u += F.G) {
        const int v = u & 255, x = v & 7, j = v >> 3, p = x + 8 * (j >> 3), sl = j & 7;
        gla_scan_unit(F, P, u >= 256, p >> 2, p & 3, sl, QK, V1, Ob, g2_probe_acc);
    }
#ifdef PROBE_G2
    if (blockIdx.x == 0 && F.tid == (PROBE_G2 == 4 ? 256 : 0)) { const unsigned long long t0_ = __builtin_amdgcn_s_memrealtime(); while (__builtin_amdgcn_s_memrealtime() - t0_ < g2_probe_acc) __builtin_amdgcn_s_sleep(8); }
#endif
}

DI void phase_gla_gate(const Frame& F, CParams& P, bf16* Ob, const bf16* Rb) {
    const int gw = F.vcu * 8 + F.wave, NGW = F.G * 8, lane = F.lane;
    const float* SSQ = (const float*)(P.ws + WS_SSQ); const float* gn = P.in[15];
    for (int m = gw; m < MV; m += NGW) {
        float sq = lane < 32 ? SSQ[(size_t)m * 32 + lane] : 0.f;
        sq += __shfl_xor(sq, 1); sq += __shfl_xor(sq, 2); sq += __shfl_xor(sq, 4);
        const float rsv = 1.0f / sqrtf(sq * (1.0f / GDV) + EPS);
#pragma unroll
        for (int j = 0; j < 4; ++j) {
            const float rs = __shfl(rsv, 8 * j);
            const int col = 8 * lane + 512 * j;
            const u32x4 ov = *(const u32x4*)(Ob + (size_t)m * D + col), rv = *(const u32x4*)(Rb + (size_t)m * D + col);
            const f32x4 g0 = *(const f32x4*)(gn + col), g1 = *(const f32x4*)(gn + col + 4);
            u32x4 y;
            y.x = pk2(bflo(ov.x) * rs * g0[0] * bflo(rv.x), bfhi(ov.x) * rs * g0[1] * bfhi(rv.x));
            y.y = pk2(bflo(ov.y) * rs * g0[2] * bflo(rv.y), bfhi(ov.y) * rs * g0[3] * bfhi(rv.y));
            y.z = pk2(bflo(ov.z) * rs * g1[0] * bflo(rv.z), bfhi(ov.z) * rs * g1[1] * bfhi(rv.z));
            y.w = pk2(bflo(ov.w) * rs * g1[2] * bflo(rv.w), bfhi(ov.w) * rs * g1[3] * bfhi(rv.w));
            *(u32x4*)(Ob + (size_t)m * D + col) = y;
        }
    }
}

DI void phase_final_norm(const Frame& F, CParams& P, const bf16* X2) {
    const int gw = F.vcu * 8 + F.wave, NGW = F.G * 8, lane = F.lane;
    const float* fg = P.in[17]; const float* SS2 = (const float*)(P.ws + WS_SS2);
    for (int m = gw; m < MV; m += NGW) {
        float ss = lane < 32 ? SS2[(size_t)m * 32 + lane] : 0.f;
        ss = wave_sum(ss);
        const float rstd = 1.0f / sqrtf(ss * (1.0f / D) + EPS);
        const u32x4* xr = (const u32x4*)(X2 + (size_t)m * D) + lane;
        float* yo = P.out + OY + (size_t)m * D + 8 * lane;
#pragma unroll
        for (int j = 0; j < 4; ++j) {
            const u32x4 xv = xr[64 * j];
            const f32x4 g0 = *(const f32x4*)(fg + 8 * lane + 512 * j), g1 = *(const f32x4*)(fg + 8 * lane + 512 * j + 4);
            const f32x4 y0 = (f32x4){bflo(xv.x), bfhi(xv.x), bflo(xv.y), bfhi(xv.y)} * rstd * g0, y1 = (f32x4){bflo(xv.z), bfhi(xv.z), bflo(xv.w), bfhi(xv.w)} * rstd * g1;
            __builtin_nontemporal_store(y0, (f32x4*)(yo + 512 * j)); __builtin_nontemporal_store(y1, (f32x4*)(yo + 512 * j + 4));
        }
    }
}

DI void phase_norm_mod_alr_generic(const Frame& F, CParams& P, const bf16* X1, bf16* H) {
    const int gw = F.vcu * 8 + F.wave, NGW = F.G * 8, lane = F.lane, i16 = lane & 15, g4 = lane >> 4;
    const float* ADA = (const float*)(P.ws + WS_ADA) + (size_t)16 * 6144;
    const float* ng = P.in[9] + D;
    const float* SS2 = (const float*)(P.ws + WS_SS2);
    const bf16* WA = (const bf16*)(P.ws + WS_WA);
    float* ALR = (float*)(P.ws + WS_ALR);
    for (int tk = gw; tk < MT / 16; tk += NGW) {
        const size_t m = (size_t)16 * tk + i16;
        if (16 * tk >= MV) {
            u32x4* o = (u32x4*)(H + m * D) + g4;
#pragma unroll 8
            for (int ks = 0; ks < 64; ++ks) o[4 * ks] = (u32x4){0u, 0u, 0u, 0u};
            continue;
        }
        const int ai = tk < MP / 16 ? (tk >> 8) : 8 + (tk - MP / 16);
        const float* sh = ADA + (size_t)ai * 6144, *sc = sh + 2048;
        float ss = 0.f;
        { const f32x4 a = *(const f32x4*)(SS2 + m * 32 + 8 * g4), b2 = *(const f32x4*)(SS2 + m * 32 + 8 * g4 + 4); ss = (a[0] + a[1]) + (a[2] + a[3]) + (b2[0] + b2[1]) + (b2[2] + b2[3]); }
        ss += __shfl_xor(ss, 16); ss += __shfl_xor(ss, 32);
        const float rstd = 1.0f / sqrtf(ss * (1.0f / D) + EPS);
        const bf16* xrow = X1 + m * D;
        f32x4 acc = {0.f, 0.f, 0.f, 0.f};
#pragma unroll 4
        for (int ks = 0; ks < 64; ++ks) {
            const int k0 = 32 * ks + 8 * g4;
            const u32x4 xv = *(const u32x4*)(xrow + k0);
            const f32x4 x0 = {bflo(xv.x), bfhi(xv.x), bflo(xv.y), bfhi(xv.y)}, x1 = {bflo(xv.z), bfhi(xv.z), bflo(xv.w), bfhi(xv.w)};
            const f32x4 gA = *(const f32x4*)(ng + k0), gB = *(const f32x4*)(ng + k0 + 4);
            const f32x4 cA = *(const f32x4*)(sc + k0), cB = *(const f32x4*)(sc + k0 + 4);
            const f32x4 hA = *(const f32x4*)(sh + k0), hB = *(const f32x4*)(sh + k0 + 4);
            const bf16x8 bfr = *(const bf16x8*)(WA + i16 * D + k0);
            const f32x4 y0 = (x0 * rstd) * gA * (cA + 1.0f) + hA, y1 = (x1 * rstd) * gB * (cB + 1.0f) + hB;
            u32x4 w; w.x = pk2(y0[0], y0[1]); w.y = pk2(y0[2], y0[3]); w.z = pk2(y1[0], y1[1]); w.w = pk2(y1[2], y1[3]);
            *(u32x4*)(H + m * D + k0) = w;
            acc = __builtin_amdgcn_mfma_f32_16x16x32_bf16(__builtin_bit_cast(bf16x8, w), bfr, acc, 0, 0, 0);
        }
#pragma unroll
        for (int e = 0; e < 4; ++e) ALR[((size_t)16 * tk + 4 * g4 + e) * 16 + i16] = acc[e];
    }
}

constexpr int P5_WAP = 4112;
constexpr int P5_WA = 0, P5_GM = 16 * P5_WAP, P5_SH = P5_GM + 8192, P5_RED = P5_SH + 8192;
DI void p5_tables(const Frame& F, CParams& P, int ai) {
    const float* ADA = (const float*)(P.ws + WS_ADA) + (size_t)16 * 6144 + (size_t)ai * 6144;
    const float* ng = P.in[9] + D;
    { const int c = 4 * F.tid;
      const f32x4 g = *(const f32x4*)(ng + c), sc = *(const f32x4*)(ADA + 2048 + c), sh = *(const f32x4*)(ADA + c);
      *(LAS f32x4*)(F.lds + P5_GM + c * 4) = g * (sc + 1.0f); *(LAS f32x4*)(F.lds + P5_SH + c * 4) = sh; }
}
DI f32x4 p5_rows(const Frame& F, const bf16* X1, bf16* H, size_t m, float rstd, int ks_lo, int ks_hi, int i16, int g4) {
    const bf16* xrow = X1 + m * D;
    f32x4 accq[4];
#pragma unroll
    for (int q = 0; q < 4; ++q) accq[q] = (f32x4){0.f, 0.f, 0.f, 0.f};
    for (int ks0 = ks_lo; ks0 < ks_hi; ks0 += 8) {
        u32x4 xv[8];
#pragma unroll
        for (int q = 0; q < 8; ++q) xv[q] = *(const u32x4*)(xrow + 32 * (ks0 + q) + 8 * g4);
#pragma unroll
        for (int q = 0; q < 8; ++q) {
            const int k0 = 32 * (ks0 + q) + 8 * g4;
            const f32x4 x0 = {bflo(xv[q].x), bfhi(xv[q].x), bflo(xv[q].y), bfhi(xv[q].y)}, x1 = {bflo(xv[q].z), bfhi(xv[q].z), bflo(xv[q].w), bfhi(xv[q].w)};
            const f32x4 gA = *(const LAS f32x4*)(F.lds + P5_GM + k0 * 4), gB = *(const LAS f32x4*)(F.lds + P5_GM + k0 * 4 + 16);
            const f32x4 hA = *(const LAS f32x4*)(F.lds + P5_SH + k0 * 4), hB = *(const LAS f32x4*)(F.lds + P5_SH + k0 * 4 + 16);
            const bf16x8 bfr = *(const LAS bf16x8*)(F.lds + P5_WA + i16 * P5_WAP + k0 * 2);
            const f32x4 y0 = (x0 * rstd) * gA + hA, y1 = (x1 * rstd) * gB + hB;
            u32x4 w; w.x = pk2(y0[0], y0[1]); w.y = pk2(y0[2], y0[3]); w.z = pk2(y1[0], y1[1]); w.w = pk2(y1[2], y1[3]);
            *(u32x4*)(H + m * D + k0) = w;
            accq[q & 3] = __builtin_amdgcn_mfma_f32_16x16x32_bf16(__builtin_bit_cast(bf16x8, w), bfr, accq[q & 3], 0, 0, 0);
        }
    }
    return (accq[0] + accq[1]) + (accq[2] + accq[3]);
}
DI float p5_rstd(const float* SS2, size_t m, int g4) {
    const f32x4 a = *(const f32x4*)(SS2 + m * 32 + 8 * g4), b2 = *(const f32x4*)(SS2 + m * 32 + 8 * g4 + 4);
    float ss = (a[0] + a[1]) + (a[2] + a[3]) + (b2[0] + b2[1]) + (b2[2] + b2[3]);
    ss += __shfl_xor(ss, 16); ss += __shfl_xor(ss, 32);
    return 1.0f / sqrtf(ss * (1.0f / D) + EPS);
}
DI void phase_norm_mod_alr(const Frame& F, CParams& P, const bf16* X1, bf16* H) {
    if (F.G != 256) { phase_norm_mod_alr_generic(F, P, X1, H); return; }
    const int lane = F.lane, i16 = lane & 15, g4 = lane >> 4, v = F.vcu, w = F.wave;
    const float* SS2 = (const float*)(P.ws + WS_SS2);
    const bf16* WA = (const bf16*)(P.ws + WS_WA);
    float* ALR = (float*)(P.ws + WS_ALR);
    for (int idx = F.tid; idx < 4096; idx += 512) { const int r = idx >> 8, ch = idx & 255; *(LAS u32x4*)(F.lds + P5_WA + r * P5_WAP + ch * 16) = *(const u32x4*)(WA + r * D + ch * 8); }
    p5_tables(F, P, v >> 5);
    __syncthreads();
    {
        const size_t m = (size_t)128 * v + 16 * w + i16;
        const f32x4 acc = p5_rows(F, X1, H, m, p5_rstd(SS2, m, g4), 0, 64, i16, g4);
#pragma unroll
        for (int e = 0; e < 4; ++e) ALR[((size_t)128 * v + 16 * w + 4 * g4 + e) * 16 + i16] = acc[e];
    }
    if (v < 8) {
        __syncthreads();
        p5_tables(F, P, 8 + v);
        __syncthreads();
        const size_t m = (size_t)MP + 16 * v + i16;
        const f32x4 acc = p5_rows(F, X1, H, m, p5_rstd(SS2, m, g4), 8 * w, 8 * w + 8, i16, g4);
        LAS float* red = (LAS float*)(F.lds + P5_RED) + w * 256;
#pragma unroll
        for (int e = 0; e < 4; ++e) red[(4 * g4 + e) * 16 + i16] = acc[e];
        __syncthreads();
        if (F.tid < 256) { float sum = 0.f;
#pragma unroll
            for (int wv = 0; wv < 8; ++wv) sum += *((const LAS float*)(F.lds + P5_RED) + wv * 256 + F.tid);
            ALR[((size_t)MP + 16 * v) * 16 + F.tid] = sum; }
    }
}

__global__ void __launch_bounds__(512, 2) fwd_kernel(Params P_arg) {
    extern __shared__ __attribute__((aligned(16))) unsigned char lds_raw[];
    (void)P_arg;
    CParams& P = *(CParams*)__builtin_amdgcn_kernarg_segment_ptr();
    Frame F;
    F.lds = (LAS unsigned char*)lds_raw;
    F.tid = threadIdx.x; F.lane = F.tid & 63; F.wave = __builtin_amdgcn_readfirstlane(F.tid >> 6);
    F.G = gridDim.x; { const int bx = blockIdx.x; F.vcu = (F.G % 8 == 0) ? (bx % 8) * (F.G / 8) + bx / 8 : bx; }
    volatile LAS unsigned* MISC = (volatile LAS unsigned*)(F.lds + LDS_MISC);
    if (F.tid < 16) MISC[F.tid] = 0u;
    __syncthreads();
    XcdBarrier bar = xcd_barrier_post((unsigned*)(P.ws + WS_CTL) + CW_BAR, MISC);
#define R0 ((bf16*)(P.ws + WS_R0))
#define R1 ((bf16*)(P.ws + WS_R0 + RSZ))
#define R2 ((bf16*)(P.ws + WS_R0 + 2 * RSZ))
#define R3 ((bf16*)(P.ws + WS_R0 + 3 * RSZ))
#define R4 ((bf16*)(P.ws + WS_R0 + 4 * RSZ))
#define R5 ((bf16*)(P.ws + WS_R0 + 5 * RSZ))

#ifdef PROBE_MASK
    unsigned long long pr_acc = 0ull, pr_last = __builtin_amdgcn_s_memrealtime();
#define GRID_BAR(id) do { xcd_barrier(bar); { const unsigned long long now_ = __builtin_amdgcn_s_memrealtime(); if ((PROBE_MASK >> (id)) & 1u) pr_acc += now_ - pr_last; pr_last = now_; } } while (0)
#else
#define GRID_BAR(id) xcd_barrier(bar)
#endif
    const bool stag = (F.G == 256);
    const int mini_xcd = (int)blockIdx.x & 7, mini_idx = ((int)blockIdx.x >> 3) * 4 + (mini_xcd & 3);
#define MINI_EARLY(A_, Bt_, N_, ME_) do { if (stag && mini_xcd < 4) mini_gemm(F, A_, Bt_, ME_, mini_idx, 128, (N_) / 16 < 256 ? (N_) / 16 : 256); } while (0)
#define MINI_LATE(A_, Bt_, N_, ME_) do { if (!stag) mini_gemm(F, A_, Bt_, ME_, (int)blockIdx.x, F.G, (N_) / 16); else if (mini_xcd >= 4) mini_gemm(F, A_, Bt_, ME_, 256 + mini_idx, 128, (N_) / 16); } while (0)
    phase0_ada(F, P);
    GRID_BAR(0);
    phase0_transposes(F, P);
    phase_norm_mod(F, P, 0, R0);
    GRID_BAR(1);
    {
        pg8::Gemm g{R0, (const bf16*)(P.ws + WS_W1T), MP, 8192, D}; pg8::StaticOrder S; S.init(MP, 8192, F.G, (int)blockIdx.x);
        Epi1 E{P.ws, 0.08838834764831845f * 1.4426950408889634f};
        Mini1 ME{P.ws, 0.08838834764831845f * 1.4426950408889634f};
        MINI_EARLY(R0 + (size_t)MP * D, (const bf16*)(P.ws + WS_W1T), 8192, ME);
        pg8::gemm_phase<Epi1, pg8::StaticOrder, true, true>(F.lds, g, S, E);
        MINI_LATE(R0 + (size_t)MP * D, (const bf16*)(P.ws + WS_W1T), 8192, ME);
    }
#if LAST_PHASE >= 3
    GRID_BAR(2);
    phase_attn(F, P, R1, R2, R3, R4, R1);
#endif
#if LAST_PHASE >= 4
    GRID_BAR(3);
    {
        pg8::Gemm g{R1, (const bf16*)(P.ws + WS_W2T), MP, 2048, D}; pg8::StaticOrder S; S.init(MP, 2048, F.G, (int)blockIdx.x);
        EpiRes<false> E{P.in[0], R3, (const float*)(P.ws + WS_ADA) + 4096, (float*)(P.ws + WS_SS2)};
        MiniRes<false> ME{P.in[1], R3 + (size_t)MP * D, (const float*)(P.ws + WS_ADA) + 4096, (float*)(P.ws + WS_SS2)};
        MINI_EARLY(R1 + (size_t)MP * D, (const bf16*)(P.ws + WS_W2T), 2048, ME);
        pg8::gemm_phase<EpiRes<false>, pg8::StaticOrder, true, true>(F.lds, g, S, E);
        MINI_LATE(R1 + (size_t)MP * D, (const bf16*)(P.ws + WS_W2T), 2048, ME);
    }
#endif
#if LAST_PHASE >= 5
    GRID_BAR(4);
    phase_norm_mod_alr(F, P, R3, R0);
    GRID_BAR(5);
    {
        pg8::Gemm g{R0, (const bf16*)(P.ws + WS_W3T), MP, 6144, D}; pg8::StaticOrder S; S.init(MP, 6144, F.G, (int)blockIdx.x);
        Epi3 E{P.ws};
        Mini3 ME{P.ws};
        MINI_EARLY(R0 + (size_t)MP * D, (const bf16*)(P.ws + WS_W3T), 6144, ME);
        pg8::gemm_phase<Epi3, pg8::StaticOrder, true, true>(F.lds, g, S, E);
        MINI_LATE(R0 + (size_t)MP * D, (const bf16*)(P.ws + WS_W3T), 6144, ME);
    }
    GRID_BAR(6);
    phase_gla_prep(F, P, R1);
    GRID_BAR(7);
    phase_gla_scan(F, P, R1, R4, R2);
#endif
#if LAST_PHASE >= 9
    GRID_BAR(8);
    phase_gla_gate(F, P, R2, R5);
    GRID_BAR(9);
    {
        pg8::Gemm g{R2, (const bf16*)(P.ws + WS_W4T), MP, 2048, D}; pg8::StaticOrder S; S.init(MP, 2048, F.G, (int)blockIdx.x);
        EpiRes<true> E{R3, R3, (const float*)(P.ws + WS_ADA) + (size_t)16 * 6144 + 4096, (float*)(P.ws + WS_SS2)};
        MiniRes<true> ME{R3 + (size_t)MP * D, R3 + (size_t)MP * D, (const float*)(P.ws + WS_ADA) + (size_t)16 * 6144 + 4096, (float*)(P.ws + WS_SS2)};
        MINI_EARLY(R2 + (size_t)MP * D, (const bf16*)(P.ws + WS_W4T), 2048, ME);
        pg8::gemm_phase<EpiRes<true>, pg8::StaticOrder, true, true>(F.lds, g, S, E);
        MINI_LATE(R2 + (size_t)MP * D, (const bf16*)(P.ws + WS_W4T), 2048, ME);
    }
    GRID_BAR(10);
    phase_final_norm(F, P, R3);
#ifdef PROBE_MASK
    GRID_BAR(11);
    if (blockIdx.x == 0 && F.tid == 0) { const unsigned long long t0_ = __builtin_amdgcn_s_memrealtime(); while (__builtin_amdgcn_s_memrealtime() - t0_ < pr_acc * PROBE_AMP) __builtin_amdgcn_s_sleep(8); }
#endif
#endif
#if LAST_PHASE < 9
    {
        f32x4* o = (f32x4*)P.out; const f32x4 z = {0.f, 0.f, 0.f, 0.f};
        for (size_t i = (size_t)blockIdx.x * 512 + F.tid; i < OKP / 4; i += (size_t)F.G * 512) o[i] = z;
#if LAST_PHASE < 5
        for (size_t i = OSP / 4 + (size_t)blockIdx.x * 512 + F.tid; i < OUT_TOTAL / 4; i += (size_t)F.G * 512) o[i] = z;
#endif
    }
#endif
}

#undef R0
#undef R1
#undef R2
#undef R3
#undef R4
#undef R5
extern "C" void kernel_launch(void* const* d_in, const int* in_sizes, int n_in, void* d_out, int out_size, void* d_ws, size_t ws_size, hipStream_t stream) {
    static int grid = 0;
    if (grid == 0) {
        if (n_in != 18 || (size_t)out_size != OUT_TOTAL || ws_size < WS_END) { fprintf(stderr, "kernel_launch: unexpected shapes: n_in %d out %d ws %zu (need %zu)\n", n_in, out_size, ws_size, (size_t)WS_END); grid = -1; return; }
        int dev = 0, cus = 0, per_cu = 0;
        if (hipGetDevice(&dev) != hipSuccess || hipDeviceGetAttribute(&cus, hipDeviceAttributeMultiprocessorCount, dev) != hipSuccess) { grid = -1; return; }
        if (hipFuncSetAttribute((const void*)fwd_kernel, hipFuncAttributeMaxDynamicSharedMemorySize, LDS_BYTES) != hipSuccess) { fprintf(stderr, "kernel_launch: hipFuncSetAttribute failed\n"); grid = -1; return; }
        if (hipOccupancyMaxActiveBlocksPerMultiprocessor(&per_cu, (const void*)fwd_kernel, 512, LDS_BYTES) != hipSuccess || per_cu < 1) fprintf(stderr, "kernel_launch: occupancy query reports %d\n", per_cu);
        (void)hipGetLastError();
        grid = cus;
    }
    if (grid < 0) return;
    (void)in_sizes;
    hipMemsetAsync((char*)d_ws + WS_CTL, 0, CTL_ZERO_BYTES, stream);
    Params p{};
    for (int i = 0; i < 18; ++i) p.in[i] = (const float*)d_in[i];
    p.out = (float*)d_out; p.ws = (unsigned char*)d_ws;
    hipLaunchKernelGGL(fwd_kernel, dim3(grid), dim3(512), LDS_BYTES, stream, p);
}
```
